# Optimizing an MI355X kernel written in HIP

```python
import math
import jax, jax.numpy as jnp
from jax import lax
import numpy as np

D_MODEL = 1024
BATCH = 8
SEQ = 4096
DEPTH = 4

D_MIX = D_MODEL
M_HEADS = 4
M_DH = D_MODEL // 16
M_W = M_HEADS * M_DH
CONV_W = 4
CHUNK = 64
DF_HEADS = 4
DF_DQK = D_MODEL // 16
DF_DV = 2 * DF_DQK
DF_QK_W = DF_HEADS * 2 * DF_DQK
DF_W = DF_HEADS * DF_DV
H_HEADS = 4
H_DK = D_MODEL // 16
H_DV = D_MODEL // 16
H_W = H_HEADS * H_DV
D_FF = 2816
REL_BUCKETS = 32
REL_MAX_EXACT = 16
REL_MAX_DIST = 128
Q_BLOCK = 128
EPS = 1e-6
SPLIT_SIZES = (2 * M_W, M_W, M_W, M_HEADS, M_HEADS,
               DF_QK_W, DF_QK_W, DF_W,
               H_W, H_W, H_W, H_W)
N_IN = sum(SPLIT_SIZES)

kernel_name = 'hymba_mlstm_diffattn_hgrn2_macaron'


def rms_norm(x, w):
    xf = x.astype(jnp.float32)
    y = xf * lax.rsqrt(jnp.mean(xf * xf, axis=-1, keepdims=True) + EPS)
    return (y * w.astype(jnp.float32)).astype(x.dtype)


def head_layer_norm(x, w):
    xf = x.astype(jnp.float32)
    xc = xf - jnp.mean(xf, axis=-1, keepdims=True)
    y = xc * lax.rsqrt(jnp.mean(xc * xc, axis=-1, keepdims=True) + EPS)
    return (y * w.astype(jnp.float32)).astype(x.dtype)


def swiglu(x, wi, wo):
    g, u = jnp.split(x @ wi, 2, axis=-1)
    return (jax.nn.silu(g) * u) @ wo


def causal_short_conv(x, w, b):
    S = x.shape[1]
    K = w.shape[0]
    xp = jnp.pad(x, ((0, 0), (K - 1, 0), (0, 0)))
    y = b
    for j in range(K):
        y = y + xp[:, j:j + S, :] * w[j]
    return y


def to_heads(t, H):
    B, S, _ = t.shape
    return t.reshape(B, S, H, -1).transpose(0, 2, 1, 3)


def from_heads(t):
    return t.transpose(0, 2, 1, 3)


def to_chunks(t):
    B, H, S = t.shape[:3]
    return jnp.moveaxis(t.reshape(B, H, S // CHUNK, CHUNK, *t.shape[3:]), 2, 0)


def from_chunks(t):
    NC, B, H, L = t.shape[:4]
    return jnp.moveaxis(t, 0, 2).reshape(B, H, NC * L, *t.shape[4:])


def mlstm_chunkwise(q, k, v, log_i, log_f):
    B, H, S, d = q.shape
    tri = jnp.tril(jnp.ones((CHUNK, CHUNK), dtype=bool))

    def step(carry, xs):
        C, n, m = carry
        qc, kc, vc, li, lf = xs
        b = jnp.cumsum(lf, axis=-1)
        dmat = jnp.where(tri, b[..., :, None] - b[..., None, :] + li[..., None, :], -jnp.inf)
        m_inter = b + m[..., None]
        m_t = jnp.maximum(jnp.max(dmat, axis=-1), m_inter)
        w = jnp.exp(dmat - m_t[..., None])
        sc = jnp.einsum('bhtd,bhsd->bhts', qc, kc) * w
        g = jnp.exp(m_inter - m_t)
        num = jnp.einsum('bhts,bhse->bhte', sc, vc) + g[..., None] * jnp.einsum('bhtd,bhde->bhte', qc, C)
        den = jnp.sum(sc, axis=-1) + g * jnp.einsum('bhtd,bhd->bht', qc, n)
        h = num / jnp.maximum(jnp.abs(den), jnp.exp(-m_t))[..., None]
        bl = b[..., -1]
        a = bl[..., None] - b + li
        m_new = jnp.maximum(bl + m, jnp.max(a, axis=-1))
        decay = jnp.exp(bl + m - m_new)
        wa = jnp.exp(a - m_new[..., None])
        C = decay[..., None, None] * C + jnp.einsum('bhs,bhsd,bhse->bhde', wa, kc, vc)
        n = decay[..., None] * n + jnp.einsum('bhs,bhsd->bhd', wa, kc)
        return (C, n, m_new), h

    init = (jnp.zeros((B, H, d, v.shape[-1]), jnp.float32), jnp.zeros((B, H, d), jnp.float32),
            jnp.zeros((B, H), jnp.float32))
    _, h = lax.scan(step, init, (to_chunks(q), to_chunks(k), to_chunks(v), to_chunks(log_i), to_chunks(log_f)))
    return from_chunks(h)


def hgrn2_chunkwise(q, k, v, log_f):
    B, H, S, dk = q.shape
    tri = jnp.tril(jnp.ones((CHUNK, CHUNK), dtype=bool))[:, :, None]

    def step(St, xs):
        qc, kc, vc, lf = xs
        b = jnp.cumsum(lf, axis=2)
        diff = b[:, :, :, None, :] - b[:, :, None, :, :]
        decay = jnp.exp(jnp.where(tri, diff, -jnp.inf))
        A = jnp.einsum('bhtsc,bhsc->bhts', decay * qc[:, :, :, None, :], kc)
        o = jnp.einsum('bhts,bhsv->bhtv', A, vc) + jnp.einsum('bhtc,bhcv->bhtv', qc * jnp.exp(b), St)
        bl = b[:, :, -1:, :]
        St = jnp.exp(bl[:, :, 0, :])[..., None] * St + jnp.einsum('bhsc,bhsv->bhcv', kc * jnp.exp(bl - b), vc)
        return St, o

    init = jnp.zeros((B, H, dk, v.shape[-1]), jnp.float32)
    _, o = lax.scan(step, init, (to_chunks(q), to_chunks(k), to_chunks(v), to_chunks(log_f)))
    return from_chunks(o)


def t5_bucket(rel):
    n = jnp.maximum(rel, 0)
    is_small = n < REL_MAX_EXACT
    nf = jnp.maximum(n, 1).astype(jnp.float32)
    large = REL_MAX_EXACT + (jnp.log(nf / REL_MAX_EXACT) / math.log(REL_MAX_DIST / REL_MAX_EXACT)
                             * (REL_BUCKETS - REL_MAX_EXACT)).astype(jnp.int32)
    large = jnp.minimum(large, REL_BUCKETS - 1)
    return jnp.where(is_small, n, large)


def diff_attention(q1, q2, k1, k2, v, lam, rel_bias):
    B, H, S, d = q1.shape
    nb = S // Q_BLOCK
    scale = d ** -0.5
    kpos = jnp.arange(S, dtype=jnp.int32)
    table = rel_bias.astype(jnp.float32)

    def qblocks(t):
        return jnp.moveaxis(t.reshape(B, H, nb, Q_BLOCK, t.shape[-1]), 2, 0)

    def one_block(args):
        q1b, q2b, j = args
        qpos = j * Q_BLOCK + jnp.arange(Q_BLOCK, dtype=jnp.int32)
        rel = qpos[:, None] - kpos[None, :]
        causal = rel >= 0
        bias = jnp.transpose(table[t5_bucket(rel)], (2, 0, 1))

        def probs(qb, kk):
            s = jnp.einsum('bhqd,bhkd->bhqk', qb, kk) * scale + bias
            return jax.nn.softmax(jnp.where(causal, s, -jnp.inf), axis=-1)

        a = probs(q1b, k1) - lam * probs(q2b, k2)
        return jnp.einsum('bhqk,bhkd->bhqd', a, v)

    out = lax.map(one_block, (qblocks(q1), qblocks(q2), jnp.arange(nb, dtype=jnp.int32)))
    return jnp.moveaxis(out, 0, 2).reshape(B, H, S, v.shape[-1])


def hybrid_mixer(h, layer, w_in, w_out, conv_w, conv_b, ig_b, fg_b, m_norm_w,
                 lam_vecs, df_norm_w, rel_bias, lb, hg_norm_w):
    f32 = jnp.float32
    B, S, _ = h.shape
    u = (h @ w_in).astype(f32)
    idx = [int(i) for i in np.cumsum(SPLIT_SIZES)[:-1]]
    (qk_m, v_m, o_m, i_m, f_m, q_d, k_d, v_d, q_h, f_h, i_h, g_h) = jnp.split(u, idx, axis=-1)

    qk_m = jax.nn.silu(causal_short_conv(qk_m, conv_w.astype(f32), conv_b.astype(f32)))
    q_mc, k_mc = jnp.split(qk_m, 2, axis=-1)
    qm = to_heads(q_mc, M_HEADS)
    km = to_heads(k_mc, M_HEADS) * (M_DH ** -0.5)
    vm = to_heads(v_m, M_HEADS)
    log_i = (i_m + ig_b.astype(f32)).transpose(0, 2, 1)
    log_f = jax.nn.log_sigmoid(f_m + fg_b.astype(f32)).transpose(0, 2, 1)
    hm = from_heads(mlstm_chunkwise(qm, km, vm, log_i, log_f))
    y_m = head_layer_norm(hm, m_norm_w.reshape(M_HEADS, M_DH)).reshape(B, S, M_W) * jax.nn.sigmoid(o_m)

    lam_init = 0.8 - 0.6 * math.exp(-0.3 * layer)
    lv = lam_vecs.astype(f32)
    lam = jnp.exp(jnp.sum(lv[0] * lv[1])) - jnp.exp(jnp.sum(lv[2] * lv[3])) + lam_init
    qd = q_d.reshape(B, S, DF_HEADS, 2, DF_DQK).transpose(0, 2, 1, 3, 4)
    kd = k_d.reshape(B, S, DF_HEADS, 2, DF_DQK).transpose(0, 2, 1, 3, 4)
    vd = to_heads(v_d, DF_HEADS)
    od = diff_attention(qd[..., 0, :], qd[..., 1, :], kd[..., 0, :], kd[..., 1, :], vd, lam, rel_bias)
    y_d = (rms_norm(from_heads(od), df_norm_w.reshape(DF_HEADS, DF_DV)) * (1.0 - lam_init)).reshape(B, S, DF_W)

    qh = jax.nn.silu(to_heads(q_h, H_HEADS))
    fp = to_heads(f_h, H_HEADS)
    lbh = lb.astype(f32).reshape(H_HEADS, 1, H_DK)
    log_fh = jnp.logaddexp(jnp.log(lbh), jnp.log1p(-lbh) + jax.nn.log_sigmoid(fp))
    kh = (1.0 - lbh) * jax.nn.sigmoid(-fp)
    vh = to_heads(i_h, H_HEADS)
    oh = from_heads(hgrn2_chunkwise(qh, kh, vh, log_fh))
    y_h = rms_norm(oh, hg_norm_w.reshape(H_HEADS, H_DV)).reshape(B, S, H_W) * jax.nn.silu(g_h)

    y = jnp.concatenate([y_m, y_d, y_h], axis=-1).astype(h.dtype)
    return y @ w_out


def setup_inputs(seed: int = 0) -> dict:
    key = jax.random.key(seed)
    ks = jax.random.split(key, 20)
    nrm = lambda k, shape, s: jax.random.normal(k, shape, jnp.float32) * s
    fg_base = jnp.linspace(3.0, 6.0, M_HEADS, dtype=jnp.float32)
    return {
        'x': nrm(ks[0], (BATCH, SEQ, D_MODEL), 1.0),
        'norm_w': 1.0 + nrm(ks[1], (DEPTH, 6, D_MODEL), 0.05),
        'ffn1_wi': nrm(ks[2], (DEPTH, D_MODEL, 2 * D_FF), D_MODEL ** -0.5),
        'ffn1_wo': nrm(ks[3], (DEPTH, D_FF, D_MODEL), D_FF ** -0.5),
        'ffn2_wi': nrm(ks[4], (DEPTH, D_MODEL, 2 * D_FF), D_MODEL ** -0.5),
        'ffn2_wo': nrm(ks[5], (DEPTH, D_FF, D_MODEL), D_FF ** -0.5),
        'w_in': nrm(ks[6], (DEPTH, D_MODEL, N_IN), D_MODEL ** -0.5),
        'w_out': nrm(ks[7], (DEPTH, D_MIX, D_MODEL), D_MIX ** -0.5),
        'mlstm_conv_w': nrm(ks[8], (DEPTH, CONV_W, 2 * M_W), CONV_W ** -0.5),
        'mlstm_conv_b': nrm(ks[9], (DEPTH, 2 * M_W), 0.01),
        'mlstm_igate_b': nrm(ks[10], (DEPTH, M_HEADS), 0.1),
        'mlstm_fgate_b': fg_base + nrm(ks[11], (DEPTH, M_HEADS), 0.1),
        'mlstm_norm_w': 1.0 + nrm(ks[12], (DEPTH, M_W), 0.05),
        'diff_lambda': nrm(ks[13], (DEPTH, 4, DF_DQK), 0.1),
        'diff_norm_w': 1.0 + nrm(ks[14], (DEPTH, DF_W), 0.05),
        'rel_bias': nrm(ks[15], (REL_BUCKETS, DF_HEADS), 0.5),
        'hgrn_lb_logits': nrm(ks[16], (DEPTH, H_HEADS * H_DK), 0.5),
        'hgrn_norm_w': 1.0 + nrm(ks[17], (DEPTH, H_W), 0.05),
    }


def reference(x, norm_w, ffn1_wi, ffn1_wo, ffn2_wi, ffn2_wo, w_in, w_out, mlstm_conv_w, mlstm_conv_b,
              mlstm_igate_b, mlstm_fgate_b, mlstm_norm_w, diff_lambda, diff_norm_w, rel_bias,
              hgrn_lb_logits, hgrn_norm_w):
    lb_all = jnp.cumsum(jax.nn.softmax(hgrn_lb_logits.astype(jnp.float32), axis=0), axis=0)
    lb_all = jnp.maximum(lb_all - lb_all[0:1], 0.0)
    for l in range(DEPTH):
        nw = norm_w[l]
        h = swiglu(rms_norm(x, nw[0]), ffn1_wi[l], ffn1_wo[l])
        x = x + 0.5 * rms_norm(h, nw[1])
        h = hybrid_mixer(rms_norm(x, nw[2]), l, w_in[l], w_out[l], mlstm_conv_w[l], mlstm_conv_b[l],
                         mlstm_igate_b[l], mlstm_fgate_b[l], mlstm_norm_w[l], diff_lambda[l],
                         diff_norm_w[l], rel_bias, lb_all[l], hgrn_norm_w[l])
        x = x + rms_norm(h, nw[3])
        h = swiglu(rms_norm(x, nw[4]), ffn2_wi[l], ffn2_wo[l])
        x = x + 0.5 * rms_norm(h, nw[5])
    return x
```

```cpp
#include <hip/hip_runtime.h>
#include <cstdio>
#include <cstdint>
namespace pg8 {
#define PG8_LAS __attribute__((address_space(3)))
typedef unsigned short bf16_t;
typedef short bf16x8 __attribute__((ext_vector_type(8)));
typedef float f32x4 __attribute__((ext_vector_type(4)));
typedef unsigned u32x4 __attribute__((ext_vector_type(4)));
constexpr int BM = 256, BK = 64, HALF = 128, HTB = HALF * BK * 2  , STAGE_BYTES = 8 * HTB, NXCD = 8, WGM = 8;

__host__ __device__ __forceinline__ int lds_byte(int r, int c) { const int st = (r >> 4) * 2 + (c >> 5), rr = r & 15, cc = c & 31, ob = rr * 64 + cc * 2; return st * 1024 + (ob ^ (((ob >> 9) & 1) << 5)); }
__host__ __device__ __forceinline__ void stage_rc(int b, int& R, int& C) { const int st = b / 1024, sb = b % 1024, swz = sb ^ (((sb >> 9) & 1) << 5); R = (st >> 1) * 16 + swz / 64; C = (st & 1) * 32 + (swz % 64) / 2; }
__host__ __device__ __forceinline__ int perm32(int rho) { const int n = rho >> 4, i = rho & 15; return 8 * (i >> 2) + 4 * n + (i & 3); }

struct Unit { int pm, pn; };
struct Gemm { const bf16_t* A; const bf16_t* Bt; int M, N, K; };

struct StaticOrder {
    int nM, nN, nwg, G, c;
    __host__ __device__ void init(int M, int N, int G_, int c_) { nM = M / BM; nN = N / BM; nwg = nM * nN; G = G_; c = c_; }
    __host__ __device__ bool next(int i, Unit& u) const {
        const long L = (long)i * G + c; if (L >= nwg) return false;
        int wgid = (int)L; { const int q = nwg / NXCD, r = nwg % NXCD, xcd = wgid % NXCD, off = wgid / NXCD; wgid = (xcd < r ? xcd * (q + 1) : r * (q + 1) + (xcd - r) * q) + off; }
        const int nig = WGM * nN, gid = wgid / nig, fm = gid * WGM, gsz = (nM - fm) < WGM ? (nM - fm) : WGM;
        u.pm = fm + ((wgid % nig) % gsz); u.pn = (wgid % nig) / gsz; return true;
    }
    __device__ __forceinline__ void a_ready(const Unit&) const {}
    __device__ __forceinline__ void done(const Unit&) const {}
};

__device__ __forceinline__ unsigned cvt_pk_bf16(float lo, float hi) { unsigned r; asm volatile("v_cvt_pk_bf16_f32 %0, %1, %2" : "=v"(r) : "v"(lo), "v"(hi)); return r; }
typedef float f32x2 __attribute__((ext_vector_type(2)));
struct EpiBf16 {
    static constexpr bool PERM = true, AFTER_DRAIN = false;
    bf16_t* O; int ldc;
    __device__ __forceinline__ void operator()(const f32x4 (&acc)[2][2][4][2], const Unit& u, int wr, int wc, int fr, int fq) const {
        const int row0 = u.pm * BM + wr * 64 + fr; const int col0 = u.pn * BM + wc * 32 + 8 * fq;
#pragma unroll
        for (int ai = 0; ai < 2; ++ai)
#pragma unroll
            for (int m = 0; m < 4; ++m) { bf16_t* rowp = O + (size_t)(row0 + ai * HALF + m * 16) * ldc + col0;
#pragma unroll
                for (int bj = 0; bj < 2; ++bj) { const f32x4 v0 = acc[ai][bj][m][0], v1 = acc[ai][bj][m][1];
                    u32x4 w; w.x = cvt_pk_bf16(v0[0], v0[1]); w.y = cvt_pk_bf16(v0[2], v0[3]); w.z = cvt_pk_bf16(v1[0], v1[1]); w.w = cvt_pk_bf16(v1[2], v1[3]);
                    *(u32x4*)(rowp + bj * HALF) = w; } }
    }
};
__device__ __forceinline__ float silu_f(float g) { return g * __builtin_amdgcn_rcpf(1.0f + __expf(-g)); }
struct EpiSwiGLU {
    static constexpr bool PERM = true, AFTER_DRAIN = false;
    bf16_t* O; int ldc;
    __device__ __forceinline__ void operator()(const f32x4 (&acc)[2][2][4][2], const Unit& u, int wr, int wc, int fr, int fq) const {
        const int row0 = u.pm * BM + wr * 64 + fr; const int col0 = u.pn * HALF + wc * 32 + 8 * fq;
#pragma unroll
        for (int ai = 0; ai < 2; ++ai)
#pragma unroll
            for (int m = 0; m < 4; ++m) { bf16_t* rowp = O + (size_t)(row0 + ai * HALF + m * 16) * ldc + col0;
                const f32x4 g0 = acc[ai][0][m][0], g1 = acc[ai][0][m][1], u0 = acc[ai][1][m][0], u1 = acc[ai][1][m][1];
                u32x4 w; w.x = cvt_pk_bf16(silu_f(g0[0]) * u0[0], silu_f(g0[1]) * u0[1]); w.y = cvt_pk_bf16(silu_f(g0[2]) * u0[2], silu_f(g0[3]) * u0[3]);
                w.z = cvt_pk_bf16(silu_f(g1[0]) * u1[0], silu_f(g1[1]) * u1[1]); w.w = cvt_pk_bf16(silu_f(g1[2]) * u1[2], silu_f(g1[3]) * u1[3]);
                *(u32x4*)rowp = w; }
    }
};
template <class Epi, class Sched, bool ALIGN_EPI = false, bool SP2 = false>
__device__ __forceinline__ void gemm_phase(PG8_LAS unsigned char* lds, const Gemm g, const Sched& S, const Epi& E) {
    const int tid = threadIdx.x, wid = __builtin_amdgcn_readfirstlane(tid >> 6), lane = tid & 63, wr = wid >> 2, wc = wid & 3, fr = lane & 15, fq = lane >> 4;
    const int K = g.K, nt = K / BK;
    unsigned voffA[2], voffB[2];
#pragma unroll
    for (int i = 0; i < 2; ++i) { int R, C; stage_rc(tid * 16 + i * 8192, R, C); const int Rb = Epi::PERM ? ((R & ~31) + perm32(R & 31)) : R;
        voffA[i] = (unsigned)(R * K + C) * 2u; voffB[i] = (unsigned)(Rb * K + C) * 2u; }
    const size_t kstep = (size_t)(BK * 2);
    const size_t hstep = (size_t)HALF * K * 2;
    const size_t tstep = 2 * hstep;
    const unsigned ldsw = (unsigned)wid * 1024u;
    const int aoff = lds_byte(wr * 64 + fr, fq * 8), boff = lds_byte(wc * 32 + fr, fq * 8);
#define PG8_SA(b, h) (((b) * 2 + (h)) * HTB)
#define PG8_SB(b, h) ((4 + (b) * 2 + (h)) * HTB)
#define PG8_STAGE(bufoff, gbase, voff) do { _Pragma("unroll") for (int _i = 0; _i < 2; ++_i) \
        __builtin_amdgcn_global_load_lds((const unsigned*)((const char*)(gbase) + (voff)[_i]), (PG8_LAS unsigned*)(lds + (bufoff) + ldsw + _i * 8192), 16, 0, 0); } while (0)
#define PG8_LDA(dst, b, h) do { _Pragma("unroll") for (int m = 0; m < 4; ++m) _Pragma("unroll") for (int k = 0; k < 2; ++k) dst[m][k] = *(const PG8_LAS bf16x8*)(lds + PG8_SA(b, h) + aoff + m * 2048 + k * 1024); } while (0)
#define PG8_LDB(dst, b, h) do { _Pragma("unroll") for (int n = 0; n < 2; ++n) _Pragma("unroll") for (int k = 0; k < 2; ++k) dst[n][k] = *(const PG8_LAS bf16x8*)(lds + PG8_SB(b, h) + boff + n * 2048 + k * 1024); } while (0)
#define PG8_MMA(ai, bj, At, Bt) do { __builtin_amdgcn_s_setprio(1); _Pragma("unroll") for (int m = 0; m < 4; ++m) _Pragma("unroll") for (int n = 0; n < 2; ++n) _Pragma("unroll") for (int k = 0; k < 2; ++k) \
        acc[ai][bj][m][n] = __builtin_amdgcn_mfma_f32_16x16x32_bf16(Bt[n][k], At[m][k], acc[ai][bj][m][n], 0, 0, 0); __builtin_amdgcn_s_setprio(0); } while (0)
#define PG8_WAIT_V(n) asm volatile("s_waitcnt vmcnt(" #n ")" ::: "memory")
#define PG8_WAIT_L(n) asm volatile("s_waitcnt lgkmcnt(" #n ")" ::: "memory")
#define PG8_BAR __builtin_amdgcn_s_barrier()
#define PG8_SCHED __builtin_amdgcn_sched_barrier(0)
    Unit cur, nxt; int ui = 0;
    if (!S.next(0, cur)) return;
    f32x4 acc[2][2][4][2];
#pragma unroll
    for (int a = 0; a < 2; ++a)
#pragma unroll
        for (int b = 0; b < 2; ++b)
#pragma unroll
            for (int m = 0; m < 4; ++m)
#pragma unroll
                for (int n = 0; n < 2; ++n) acc[a][b][m][n] = (f32x4){0.f, 0.f, 0.f, 0.f};
    bf16x8 At[4][2], B0[2][2], B1[2][2];
    const char* cA = (const char*)g.A + (size_t)cur.pm * tstep; const char* cB = (const char*)g.Bt + (size_t)cur.pn * tstep;
    S.a_ready(cur);
    if constexpr (SP2) {
        PG8_STAGE(PG8_SB(0, 0), cB, voffB); PG8_STAGE(PG8_SB(0, 1), cB + hstep, voffB); PG8_STAGE(PG8_SA(0, 0), cA, voffA); PG8_STAGE(PG8_SA(0, 1), cA + hstep, voffA);
        if (wr == 1) PG8_BAR;
        PG8_WAIT_V(2); PG8_BAR;
        PG8_STAGE(PG8_SB(1, 0), cB + kstep, voffB); PG8_STAGE(PG8_SA(1, 0), cA + kstep, voffA); PG8_STAGE(PG8_SB(1, 1), cB + hstep + kstep, voffB);
        PG8_WAIT_V(6); PG8_BAR;
    } else {
        PG8_STAGE(PG8_SB(0, 0), cB, voffB); PG8_STAGE(PG8_SA(0, 0), cA, voffA); PG8_STAGE(PG8_SB(0, 1), cB + hstep, voffB); PG8_STAGE(PG8_SA(0, 1), cA + hstep, voffA);
        if (wr == 1) PG8_BAR;
        PG8_WAIT_V(4); PG8_BAR;
        PG8_STAGE(PG8_SB(1, 0), cB + kstep, voffB); PG8_STAGE(PG8_SA(1, 0), cA + kstep, voffA); PG8_STAGE(PG8_SB(1, 1), cB + hstep + kstep, voffB);
        PG8_WAIT_V(6); PG8_BAR;
    }
    for (;;) {
        const bool has_next = S.next(ui + 1, nxt);
        const char* nA = has_next ? (const char*)g.A + (size_t)nxt.pm * tstep : cA; const char* nB = has_next ? (const char*)g.Bt + (size_t)nxt.pn * tstep : cB;
        for (int t = 0; t < nt; t += 2) {
            const bool last = (t == nt - 2);
            const char* a1 = cA + (size_t)(t + 1) * kstep;
            const char* a2 = last ? nA : cA + (size_t)(t + 2) * kstep; const char* b2 = last ? nB : cB + (size_t)(t + 2) * kstep;
            const char* a3 = a2 + kstep; const char* b3 = b2 + kstep;
            if (last && has_next) S.a_ready(nxt);
            if constexpr (SP2) {
            PG8_LDB(B0, 0, 0); PG8_LDB(B1, 0, 1); PG8_SCHED; PG8_LDA(At, 0, 0); PG8_STAGE(PG8_SA(1, 1), a1 + hstep, voffA);
            PG8_WAIT_V(8); PG8_WAIT_L(0); PG8_BAR; PG8_MMA(0, 0, At, B0); PG8_MMA(0, 1, At, B1); PG8_BAR; PG8_SCHED;
            PG8_LDA(At, 0, 1); PG8_STAGE(PG8_SB(0, 0), b2, voffB); PG8_STAGE(PG8_SB(0, 1), b2 + hstep, voffB); PG8_STAGE(PG8_SA(0, 0), a2, voffA);
            PG8_WAIT_V(8); PG8_WAIT_L(0); PG8_BAR; PG8_MMA(1, 0, At, B0); PG8_MMA(1, 1, At, B1); PG8_BAR; PG8_SCHED;
            PG8_LDB(B0, 1, 0); PG8_LDB(B1, 1, 1); PG8_SCHED; PG8_LDA(At, 1, 0); PG8_STAGE(PG8_SA(0, 1), a2 + hstep, voffA);
            PG8_WAIT_V(8); PG8_WAIT_L(0); PG8_BAR; PG8_MMA(0, 0, At, B0); PG8_MMA(0, 1, At, B1); PG8_BAR; PG8_SCHED;
            PG8_LDA(At, 1, 1); PG8_STAGE(PG8_SB(1, 0), b3, voffB); PG8_STAGE(PG8_SB(1, 1), b3 + hstep, voffB); PG8_STAGE(PG8_SA(1, 0), a3, voffA);
            PG8_WAIT_V(8); PG8_WAIT_L(0); PG8_BAR; PG8_MMA(1, 0, At, B0); PG8_MMA(1, 1, At, B1); PG8_BAR; PG8_SCHED;
            } else {
            PG8_LDB(B0, 0, 0); PG8_SCHED; PG8_LDA(At, 0, 0); PG8_STAGE(PG8_SA(1, 1), a1 + hstep, voffA);
            PG8_WAIT_L(8); PG8_BAR; PG8_WAIT_L(0); PG8_MMA(0, 0, At, B0); PG8_BAR; PG8_SCHED;
            PG8_LDB(B1, 0, 1); PG8_STAGE(PG8_SB(0, 0), b2, voffB);
            PG8_BAR; PG8_WAIT_L(0); PG8_MMA(0, 1, At, B1); PG8_BAR;
            PG8_LDA(At, 0, 1); PG8_STAGE(PG8_SA(0, 0), a2, voffA);
            PG8_BAR; PG8_WAIT_L(0); PG8_MMA(1, 0, At, B0); PG8_BAR; PG8_SCHED;
            PG8_STAGE(PG8_SB(0, 1), b2 + hstep, voffB);
            PG8_WAIT_V(6); PG8_BAR; PG8_MMA(1, 1, At, B1); PG8_BAR;
            PG8_LDB(B0, 1, 0); PG8_SCHED; PG8_LDA(At, 1, 0); PG8_STAGE(PG8_SA(0, 1), a2 + hstep, voffA);
            PG8_WAIT_L(8); PG8_BAR; PG8_WAIT_L(0); PG8_MMA(0, 0, At, B0); PG8_BAR; PG8_SCHED;
            PG8_LDB(B1, 1, 1); PG8_STAGE(PG8_SB(1, 0), b3, voffB);
            PG8_BAR; PG8_WAIT_L(0); PG8_MMA(0, 1, At, B1); PG8_BAR;
            PG8_LDA(At, 1, 1); PG8_STAGE(PG8_SA(1, 0), a3, voffA);
            PG8_BAR; PG8_WAIT_L(0); PG8_MMA(1, 0, At, B0); PG8_BAR; PG8_SCHED;
            PG8_STAGE(PG8_SB(1, 1), b3 + hstep, voffB);
            PG8_WAIT_V(6); PG8_BAR; PG8_MMA(1, 1, At, B1); PG8_BAR;
            }
        }
        if constexpr (ALIGN_EPI) { if (wr == 0) PG8_BAR; }
        if constexpr (!Epi::AFTER_DRAIN) { E(acc, cur, wr, wc, fr, fq); S.done(cur); }
        if (!has_next) break;
#pragma unroll
        for (int a = 0; a < 2; ++a)
#pragma unroll
            for (int b = 0; b < 2; ++b)
#pragma unroll
                for (int m = 0; m < 4; ++m)
#pragma unroll
                    for (int n = 0; n < 2; ++n) acc[a][b][m][n] = (f32x4){0.f, 0.f, 0.f, 0.f};
        cur = nxt; cA = nA; cB = nB; ++ui;
        if constexpr (ALIGN_EPI) { if (wr == 1) PG8_BAR; }
    }
    PG8_WAIT_V(0);
    if constexpr (!ALIGN_EPI) { if (wr == 0) PG8_BAR; }
    PG8_BAR;
    if constexpr (Epi::AFTER_DRAIN) { E.fused(acc, cur, wr, wc, fr, fq, lds, wid, lane); S.done(cur); }
#undef PG8_SA
#undef PG8_SB
#undef PG8_STAGE
#undef PG8_LDA
#undef PG8_LDB
#undef PG8_MMA
#undef PG8_WAIT_V
#undef PG8_WAIT_L
#undef PG8_BAR
#undef PG8_SCHED
}
}
constexpr int NB = 8, S = 4096, D = 1024, M = NB * S, DEPTH = 4, FF = 2816, NU = 3584, NIN = 3592;
constexpr float EPS = 1e-6f;
constexpr int U_QKM = 0, U_VM = 512, U_OM = 768, U_QD = 1024, U_KD = 1536, U_VD = 2048, U_QH = 2560, U_FH = 2816, U_IH = 3072, U_GH = 3328;
constexpr int Y_M = 0, Y_D = 256, Y_H = 768;
typedef unsigned short bf16;
typedef float f32x4 __attribute__((ext_vector_type(4)));
typedef unsigned v4u __attribute__((ext_vector_type(4)));
typedef unsigned v2u __attribute__((ext_vector_type(2)));
#define LAS __attribute__((address_space(3)))
#define LDS_WAIT() asm volatile("s_waitcnt lgkmcnt(0)" ::: "memory")

constexpr size_t MiB = 1u << 20;
constexpr size_t WS_CTL = 0, WS_GW = 1 * MiB, WS_WI = 2 * MiB, WS_WO = 14 * MiB, WS_WIN = 20 * MiB, WS_WOUT = 28 * MiB, WS_GATES = 30 * MiB;
constexpr size_t WS_XN = 32 * MiB, WS_U = 96 * MiB, WS_HOUT = 320 * MiB, WS_Y = 384 * MiB, WS_END = 448 * MiB;

__device__ __forceinline__ float bf2f(unsigned v) { return __uint_as_float(v << 16); }
__device__ __forceinline__ unsigned f2bf(float f) { unsigned u = __float_as_uint(f); return (u + 0x7fffu + ((u >> 16) & 1u)) >> 16; }
__device__ __forceinline__ unsigned pk2(float lo, float hi) { return f2bf(lo) | (f2bf(hi) << 16); }
__device__ __forceinline__ float wave_sum(float v) {
#pragma unroll
    for (int o = 1; o < 64; o <<= 1) v += __shfl_xor(v, o);
    return v;
}
__device__ __forceinline__ float sigmoid_f(float x) { return 1.0f / (1.0f + expf(-x)); }

template <int KIND> __device__ __forceinline__ int srccol(int n) {
    if (KIND == 1) { const int pn = n >> 8, j = n & 255; return j < 128 ? 128 * pn + j : FF + 128 * pn + (j - 128); }
    if (KIND == 2) return n < 1024 ? n : n + 8;
    return n;
}
template <int KIND> __device__ __forceinline__ void wconv_items(const float* W, int K, int Nsrc, int N, const float* nw, bf16* Bt, LAS float* scr, int gw, int NGW, int lane) {
    const int nblk = N / 32, nitems = (K / 64) * nblk;
    for (int it = gw; it < nitems; it += NGW) {
        const int kb = it / nblk, nb = it % nblk, k0 = 64 * kb, n0 = 32 * nb, sc0 = srccol<KIND>(n0);
#pragma unroll 8
        for (int i = 0; i < 32; ++i) { const int kk = 2 * i + (lane >> 5); float v = W[(size_t)(k0 + kk) * Nsrc + sc0 + (lane & 31)]; if (nw) v *= nw[k0 + kk]; scr[kk * 33 + (lane & 31)] = v; }
        LDS_WAIT();
        const int c = lane & 7;
#pragma unroll
        for (int j = 0; j < 4; ++j) { const int n = (lane >> 3) + 8 * j; const LAS float* s = scr + (8 * c) * 33 + n;
            v4u o; o.x = pk2(s[0 * 33], s[1 * 33]); o.y = pk2(s[2 * 33], s[3 * 33]); o.z = pk2(s[4 * 33], s[5 * 33]); o.w = pk2(s[6 * 33], s[7 * 33]);
            *(v4u*)(Bt + (size_t)(n0 + n) * K + k0 + 8 * c) = o; }
        LDS_WAIT();
    }
}
template <int KIND> __global__ __launch_bounds__(256) void k_wconv(const float* W, int K, int Nsrc, int N, const float* nw, bf16* Bt) {
    __shared__ float scr_all[4 * 64 * 33];
    const int wave = threadIdx.x >> 6, lane = threadIdx.x & 63;
    wconv_items<KIND>(W, K, Nsrc, N, nw, Bt, (LAS float*)scr_all + wave * 64 * 33, blockIdx.x * 4 + wave, gridDim.x * 4, lane);
}
__global__ void k_gw(const float* w_in, const float* nw, float* GW) {
    const int idx = blockIdx.x * blockDim.x + threadIdx.x; if (idx >= 8 * D) return;
    const int j = idx / D, k = idx % D; GW[idx] = nw[k] * w_in[(size_t)k * NIN + 1024 + j];
}

template <int MODE, bool GATES> __device__ __forceinline__ void thin_rows(const float* xin, float* xout, const bf16* h, const float* wa, float c, bf16* xn, const float* GW, float* gates, int gw, int NGW, int lane) {
    float gwr[8][16];
    if (GATES) {
#pragma unroll
        for (int jg = 0; jg < 8; ++jg)
#pragma unroll
            for (int j = 0; j < 4; ++j) { const f32x4 t = *(const f32x4*)(GW + jg * D + 4 * lane + 256 * j); gwr[jg][4 * j] = t.x; gwr[jg][4 * j + 1] = t.y; gwr[jg][4 * j + 2] = t.z; gwr[jg][4 * j + 3] = t.w; }
    }
    f32x4 wav[4];
    if (MODE == 1) {
#pragma unroll
        for (int j = 0; j < 4; ++j) wav[j] = *(const f32x4*)(wa + 4 * lane + 256 * j);
    }
    for (int m = gw; m < M; m += NGW) {
        const float* xr = (MODE == 0 ? xin : xout) + (size_t)m * D + 4 * lane;
        f32x4 xv[4];
#pragma unroll
        for (int j = 0; j < 4; ++j) xv[j] = *(const f32x4*)(xr + 256 * j);
        if (MODE == 1) {
            f32x4 hv[4]; float ss = 0.f;
#pragma unroll
            for (int j = 0; j < 4; ++j) { const v2u t = *(const v2u*)(h + (size_t)m * D + 4 * lane + 256 * j);
                hv[j].x = bf2f(t.x & 0xffffu); hv[j].y = bf2f(t.x >> 16); hv[j].z = bf2f(t.y & 0xffffu); hv[j].w = bf2f(t.y >> 16);
                ss += (hv[j].x * hv[j].x + hv[j].y * hv[j].y) + (hv[j].z * hv[j].z + hv[j].w * hv[j].w); }
            const float rh = c / sqrtf(wave_sum(ss) * (1.0f / D) + EPS);
#pragma unroll
            for (int j = 0; j < 4; ++j) xv[j] = xv[j] + hv[j] * wav[j] * rh;
        }
        float s2 = 0.f;
#pragma unroll
        for (int j = 0; j < 4; ++j) s2 += (xv[j].x * xv[j].x + xv[j].y * xv[j].y) + (xv[j].z * xv[j].z + xv[j].w * xv[j].w);
        const float rx = 1.0f / sqrtf(wave_sum(s2) * (1.0f / D) + EPS);
#pragma unroll
        for (int j = 0; j < 4; ++j) {
            *(f32x4*)(xout + (size_t)m * D + 4 * lane + 256 * j) = xv[j];
            v2u o; o.x = pk2(xv[j].x * rx, xv[j].y * rx); o.y = pk2(xv[j].z * rx, xv[j].w * rx);
            *(v2u*)(xn + (size_t)m * D + 4 * lane + 256 * j) = o;
        }
        if (GATES) {
#pragma unroll
            for (int jg = 0; jg < 8; ++jg) { float p = 0.f;
#pragma unroll
                for (int j = 0; j < 4; ++j) p += (xv[j].x * gwr[jg][4 * j] + xv[j].y * gwr[jg][4 * j + 1]) + (xv[j].z * gwr[jg][4 * j + 2] + xv[j].w * gwr[jg][4 * j + 3]);
                p = wave_sum(p); if (lane == jg) gates[(size_t)m * 8 + jg] = p * rx; }
        }
    }
}
template <int MODE, bool GATES> __global__ __launch_bounds__(512) void k_thin(const float* xin, float* xout, const bf16* h, const float* wa, float c, bf16* xn, const float* GW, float* gates) {
    thin_rows<MODE, GATES>(xin, xout, h, wa, c, xn, GW, gates, blockIdx.x * 8 + (threadIdx.x >> 6), gridDim.x * 8, threadIdx.x & 63);
}

template <int WHICH> __global__ __launch_bounds__(512, 2) void k_gemm(const bf16* A, const bf16* Bt, bf16* O, int Mr, int N, int K, int ldc) {
    extern __shared__ __attribute__((aligned(16))) unsigned char lds[];
    pg8::Gemm g{A, Bt, Mr, N, K}; pg8::StaticOrder So; So.init(Mr, N, gridDim.x, blockIdx.x);
    if (WHICH == 0) { pg8::EpiBf16 E{O, ldc}; pg8::gemm_phase<pg8::EpiBf16, pg8::StaticOrder, true, true>((PG8_LAS unsigned char*)lds, g, So, E); }
    else { pg8::EpiSwiGLU E{O, ldc}; pg8::gemm_phase<pg8::EpiSwiGLU, pg8::StaticOrder, true, true>((PG8_LAS unsigned char*)lds, g, So, E); }
}

__global__ void k_conv(const bf16* U, const float* cw, const float* cb, float* qkc) {
    const size_t idx = (size_t)blockIdx.x * blockDim.x + threadIdx.x; if (idx >= (size_t)M * 512) return;
    const int m = (int)(idx / 512), c = (int)(idx % 512), t = m % S;
    float acc = cb[c];
#pragma unroll
    for (int j = 0; j < 4; ++j) { const int tt = t - 3 + j; if (tt >= 0) acc += bf2f(U[(size_t)(m - 3 + j) * NU + U_QKM + c]) * cw[j * 512 + c]; }
    float v = acc / (1.0f + expf(-acc)); if (c >= 256) v *= 0.125f;
    qkc[idx] = v;
}
__global__ __launch_bounds__(256) void k_mlstm_naive(const float* qkc, const bf16* U, const float* gates, const float* igb, const float* fgb, const float* mnw, bf16* Y) {
    __shared__ float qs[16][64], ks[16][64], vs[16][64], fs[16], is_[16], pnum[16][4][64], pden[16][4];
    const int bh = blockIdx.x, b = bh >> 2, hd = bh & 3, tid = threadIdx.x, e = tid & 63, g = tid >> 6;
    float C[16], n[16];
#pragma unroll
    for (int j = 0; j < 16; ++j) { C[j] = 0.f; n[j] = 0.f; }
    const float ib = igb[hd], fb = fgb[hd], nwv = mnw[hd * 64 + e];
    for (int t0 = 0; t0 < S; t0 += 16) {
        const size_t m0 = (size_t)b * S + t0;
        for (int idx = tid; idx < 16 * 64; idx += 256) { const int tt = idx >> 6, d = idx & 63;
            qs[tt][d] = qkc[(m0 + tt) * 512 + hd * 64 + d]; ks[tt][d] = qkc[(m0 + tt) * 512 + 256 + hd * 64 + d]; vs[tt][d] = bf2f(U[(m0 + tt) * NU + U_VM + hd * 64 + d]); }
        if (tid < 16) { is_[tid] = expf(gates[(m0 + tid) * 8 + hd] + ib); fs[tid] = sigmoid_f(gates[(m0 + tid) * 8 + 4 + hd] + fb); }
        __syncthreads();
        for (int tt = 0; tt < 16; ++tt) {
            const float f = fs[tt], iv = is_[tt], v = vs[tt][e]; float pn = 0.f, pd = 0.f;
#pragma unroll
            for (int j = 0; j < 16; ++j) { const float kk = ks[tt][g * 16 + j] * iv, qq = qs[tt][g * 16 + j];
                C[j] = f * C[j] + kk * v; n[j] = f * n[j] + kk; pn += qq * C[j]; pd += qq * n[j]; }
            pnum[tt][g][e] = pn; if (e == 0) pden[tt][g] = pd;
        }
        __syncthreads();
#pragma unroll
        for (int r = 0; r < 4; ++r) { const int tt = r * 4 + g;
            const float num = (pnum[tt][0][e] + pnum[tt][1][e]) + (pnum[tt][2][e] + pnum[tt][3][e]);
            const float den = (pden[tt][0] + pden[tt][1]) + (pden[tt][2] + pden[tt][3]);
            const float hv = num / fmaxf(fabsf(den), 1.0f);
            const float mean = wave_sum(hv) * (1.0f / 64.0f), xc = hv - mean, var = wave_sum(xc * xc) * (1.0f / 64.0f);
            float y = xc / sqrtf(var + EPS) * nwv;
            y *= sigmoid_f(bf2f(U[(m0 + tt) * NU + U_OM + hd * 64 + e]));
            Y[(m0 + tt) * D + Y_M + hd * 64 + e] = (bf16)f2bf(y); }
        __syncthreads();
    }
}
__global__ __launch_bounds__(256) void k_hgrn_naive(const bf16* U, const float* lbl, int layer, const float* hnw, bf16* Y) {
    __shared__ float qs[16][64], ks[16][64], fs[16][64], vs[16][64], po[16][4][64], lbs[64];
    const int bh = blockIdx.x, b = bh >> 2, hd = bh & 3, tid = threadIdx.x, e = tid & 63, g = tid >> 6;
    if (tid < 64) { const int c = hd * 64 + tid; float l0 = lbl[c], l1 = lbl[256 + c], l2 = lbl[512 + c], l3 = lbl[768 + c];
        const float mx = fmaxf(fmaxf(l0, l1), fmaxf(l2, l3)); l0 = expf(l0 - mx); l1 = expf(l1 - mx); l2 = expf(l2 - mx); l3 = expf(l3 - mx);
        const float inv = 1.0f / (l0 + l1 + l2 + l3); float lb = 0.f; if (layer >= 1) lb += l1 * inv; if (layer >= 2) lb += l2 * inv; if (layer >= 3) lb += l3 * inv;
        lbs[tid] = fmaxf(lb, 0.f); }
    __syncthreads();
    float St[16];
#pragma unroll
    for (int j = 0; j < 16; ++j) St[j] = 0.f;
    const float nwv = hnw[hd * 64 + e];
    for (int t0 = 0; t0 < S; t0 += 16) {
        const size_t m0 = (size_t)b * S + t0;
        for (int idx = tid; idx < 16 * 64; idx += 256) { const int tt = idx >> 6, d = idx & 63; const bf16* ur = U + (m0 + tt) * NU + hd * 64 + d;
            const float qv = bf2f(ur[U_QH]), fp = bf2f(ur[U_FH]), lb = lbs[d];
            qs[tt][d] = qv / (1.0f + expf(-qv)); fs[tt][d] = lb + (1.0f - lb) * sigmoid_f(fp); ks[tt][d] = (1.0f - lb) * sigmoid_f(-fp); vs[tt][d] = bf2f(ur[U_IH]); }
        __syncthreads();
        for (int tt = 0; tt < 16; ++tt) {
            const float v = vs[tt][e]; float p = 0.f;
#pragma unroll
            for (int j = 0; j < 16; ++j) { const int c = g * 16 + j; St[j] = fs[tt][c] * St[j] + ks[tt][c] * v; p += qs[tt][c] * St[j]; }
            po[tt][g][e] = p;
        }
        __syncthreads();
#pragma unroll
        for (int r = 0; r < 4; ++r) { const int tt = r * 4 + g;
            const float o = (po[tt][0][e] + po[tt][1][e]) + (po[tt][2][e] + po[tt][3][e]);
            const float ms = wave_sum(o * o) * (1.0f / 64.0f);
            float y = o / sqrtf(ms + EPS) * nwv;
            const float gv = bf2f(U[(m0 + tt) * NU + U_GH + hd * 64 + e]);
            y *= gv / (1.0f + expf(-gv));
            Y[(m0 + tt) * D + Y_H + hd * 64 + e] = (bf16)f2bf(y); }
        __syncthreads();
    }
}
__device__ __forceinline__ int t5_bucket(int n) {
    if (n < 16) return n;
    const int v = 16 + (int)(logf((float)n / 16.0f) / logf(8.0f) * 16.0f); return v < 31 ? v : 31;
}
__global__ __launch_bounds__(256) void k_attn_naive(const bf16* U, const float* lamv, int layer, const float* dnw, const float* relb, bf16* Y) {
    __shared__ float q1s[32][65], q2s[32][65], k1s[32][65], k2s[32][65], vs[32][128], p1s[32][33], p2s[32][33], btab[128], lam_s[2];
    const int tid = threadIdx.x, bh = blockIdx.x & 31, qb = 127 - (blockIdx.x >> 5), b = bh >> 2, hd = bh & 3, row = tid >> 3, sub = tid & 7;
    const size_t mb = (size_t)b * S; const int q0 = qb * 32;
    if (tid < 128) btab[tid] = relb[t5_bucket(tid) * 4 + hd];
    if (tid == 128) { float a = 0.f, c = 0.f; for (int d = 0; d < 64; ++d) { a += lamv[d] * lamv[64 + d]; c += lamv[128 + d] * lamv[192 + d]; }
        const float li = 0.8f - 0.6f * expf(-0.3f * (float)layer); lam_s[0] = expf(a) - expf(c) + li; lam_s[1] = li; }
    for (int idx = tid; idx < 32 * 64; idx += 256) { const int r = idx >> 6, d = idx & 63; const bf16* ur = U + (mb + q0 + r) * NU + U_QD + hd * 128 + d; q1s[r][d] = bf2f(ur[0]); q2s[r][d] = bf2f(ur[64]); }
    float o1[16], o2[16], m1 = -INFINITY, m2 = -INFINITY, l1 = 0.f, l2 = 0.f;
#pragma unroll
    for (int c = 0; c < 16; ++c) { o1[c] = 0.f; o2[c] = 0.f; }
    const int qi = q0 + row;
    for (int kt = 0; kt <= qb; ++kt) {
        __syncthreads();
        for (int idx = tid; idx < 32 * 64; idx += 256) { const int r = idx >> 6, d = idx & 63; const bf16* ur = U + (mb + kt * 32 + r) * NU + U_KD + hd * 128 + d; k1s[r][d] = bf2f(ur[0]); k2s[r][d] = bf2f(ur[64]); }
        for (int idx = tid; idx < 32 * 128; idx += 256) { const int r = idx >> 7, d = idx & 127; vs[r][d] = bf2f(U[(mb + kt * 32 + r) * NU + U_VD + hd * 128 + d]); }
        __syncthreads();
        float s1[4], s2[4];
#pragma unroll
        for (int e = 0; e < 4; ++e) { s1[e] = 0.f; s2[e] = 0.f; }
        for (int d = 0; d < 64; ++d) { const float a1 = q1s[row][d], a2 = q2s[row][d];
#pragma unroll
            for (int e = 0; e < 4; ++e) { s1[e] += a1 * k1s[sub * 4 + e][d]; s2[e] += a2 * k2s[sub * 4 + e][d]; } }
        float t1 = -INFINITY, t2 = -INFINITY;
#pragma unroll
        for (int e = 0; e < 4; ++e) { const int kj = kt * 32 + sub * 4 + e, rel = qi - kj;
            if (rel >= 0) { const float bb = btab[rel < 127 ? rel : 127]; s1[e] = s1[e] * 0.125f + bb; s2[e] = s2[e] * 0.125f + bb; } else { s1[e] = -INFINITY; s2[e] = -INFINITY; }
            t1 = fmaxf(t1, s1[e]); t2 = fmaxf(t2, s2[e]); }
#pragma unroll
        for (int o = 1; o < 8; o <<= 1) { t1 = fmaxf(t1, __shfl_xor(t1, o)); t2 = fmaxf(t2, __shfl_xor(t2, o)); }
        const float mn1 = fmaxf(m1, t1), mn2 = fmaxf(m2, t2), al1 = expf(m1 - mn1), al2 = expf(m2 - mn2);
        float r1 = 0.f, r2 = 0.f;
#pragma unroll
        for (int e = 0; e < 4; ++e) { const float a = expf(s1[e] - mn1), c = expf(s2[e] - mn2); r1 += a; r2 += c; p1s[row][sub * 4 + e] = a; p2s[row][sub * 4 + e] = c; }
#pragma unroll
        for (int o = 1; o < 8; o <<= 1) { r1 += __shfl_xor(r1, o); r2 += __shfl_xor(r2, o); }
        l1 = l1 * al1 + r1; l2 = l2 * al2 + r2; m1 = mn1; m2 = mn2;
        __syncthreads();
#pragma unroll
        for (int c = 0; c < 16; ++c) { o1[c] *= al1; o2[c] *= al2; }
        for (int kj = 0; kj < 32; ++kj) { const float a = p1s[row][kj], c2 = p2s[row][kj];
#pragma unroll
            for (int c = 0; c < 16; ++c) { const float v = vs[kj][sub + 8 * c]; o1[c] += a * v; o2[c] += c2 * v; } }
    }
    const float lam = lam_s[0], gsc = 1.0f - lam_s[1], i1 = 1.0f / l1, i2 = lam / l2;
    float ss = 0.f;
#pragma unroll
    for (int c = 0; c < 16; ++c) { o1[c] = o1[c] * i1 - o2[c] * i2; ss += o1[c] * o1[c]; }
#pragma unroll
    for (int o = 1; o < 8; o <<= 1) ss += __shfl_xor(ss, o);
    const float r = gsc / sqrtf(ss * (1.0f / 128.0f) + EPS);
#pragma unroll
    for (int c = 0; c < 16; ++c) { const int col = sub + 8 * c; Y[(mb + qi) * D + Y_D + hd * 128 + col] = (bf16)f2bf(o1[c] * r * dnw[hd * 128 + col]); }
}

static void launch_gemm(int which, const bf16* A, const bf16* Bt, bf16* O, int N, int K, int ldc, hipStream_t st) {
    if (which == 0) hipLaunchKernelGGL(k_gemm<0>, dim3(256), dim3(512), 131072, st, A, Bt, O, M, N, K, ldc);
    else hipLaunchKernelGGL(k_gemm<1>, dim3(256), dim3(512), 131072, st, A, Bt, O, M, N, K, ldc);
}
extern "C" void kernel_launch(void* const* d_in, const int* in_sizes, int n_in, void* d_out, int out_size, void* d_ws, size_t ws_size, hipStream_t stream) {
    static int inited = 0;
    if (!inited) {
        if (n_in != 18 || in_sizes[0] != M * D || out_size != M * D || ws_size < WS_END) { fprintf(stderr, "kernel_launch: unexpected shapes n_in %d in0 %d out %d ws %zu\n", n_in, n_in > 0 ? in_sizes[0] : -1, out_size, ws_size); inited = -1; return; }
        (void)hipFuncSetAttribute((const void*)k_gemm<0>, hipFuncAttributeMaxDynamicSharedMemorySize, 131072);
        (void)hipFuncSetAttribute((const void*)k_gemm<1>, hipFuncAttributeMaxDynamicSharedMemorySize, 131072);
        inited = 1;
    }
    if (inited < 0) return;
    const float* x = (const float*)d_in[0]; const float* norm_w = (const float*)d_in[1];
    const float* ffn_wi[2] = {(const float*)d_in[2], (const float*)d_in[4]}; const float* ffn_wo[2] = {(const float*)d_in[3], (const float*)d_in[5]};
    const float* w_in = (const float*)d_in[6]; const float* w_out = (const float*)d_in[7];
    const float* conv_w = (const float*)d_in[8]; const float* conv_b = (const float*)d_in[9]; const float* igb = (const float*)d_in[10]; const float* fgb = (const float*)d_in[11];
    const float* mnw = (const float*)d_in[12]; const float* dlam = (const float*)d_in[13]; const float* dnw = (const float*)d_in[14]; const float* relb = (const float*)d_in[15];
    const float* lbl = (const float*)d_in[16]; const float* hnw = (const float*)d_in[17];
    float* out = (float*)d_out; unsigned char* ws = (unsigned char*)d_ws;
    float* GW = (float*)(ws + WS_GW); bf16* WI = (bf16*)(ws + WS_WI); bf16* WO = (bf16*)(ws + WS_WO); bf16* WIN = (bf16*)(ws + WS_WIN); bf16* WOUT = (bf16*)(ws + WS_WOUT);
    float* gates = (float*)(ws + WS_GATES); bf16* XN = (bf16*)(ws + WS_XN); bf16* U = (bf16*)(ws + WS_U); bf16* HB = U; bf16* HOUT = (bf16*)(ws + WS_HOUT); float* QKC = (float*)(ws + WS_HOUT); bf16* Y = (bf16*)(ws + WS_Y);
    hipLaunchKernelGGL((k_thin<0, false>), dim3(256), dim3(512), 0, stream, x, out, (const bf16*)nullptr, (const float*)nullptr, 0.f, XN, (const float*)nullptr, (float*)nullptr);
    for (int l = 0; l < DEPTH; ++l) {
        const float* nw = norm_w + (size_t)l * 6 * D;
        for (int half = 0; half < 2; ++half) {
            hipLaunchKernelGGL(k_wconv<1>, dim3(512), dim3(256), 0, stream, ffn_wi[half] + (size_t)l * D * 2 * FF, D, 2 * FF, 2 * FF, nw + (half ? 4 : 0) * D, WI);
            hipLaunchKernelGGL(k_wconv<0>, dim3(512), dim3(256), 0, stream, ffn_wo[half] + (size_t)l * FF * D, FF, D, D, (const float*)nullptr, WO);
            launch_gemm(1, XN, WI, HB, 2 * FF, D, FF, stream);
            launch_gemm(0, HB, WO, HOUT, D, FF, D, stream);
            if (half == 0) {
                hipLaunchKernelGGL(k_gw, dim3(32), dim3(256), 0, stream, w_in + (size_t)l * D * NIN, nw + 2 * D, GW);
                hipLaunchKernelGGL((k_thin<1, true>), dim3(256), dim3(512), 0, stream, (const float*)nullptr, out, HOUT, nw + 1 * D, 0.5f, XN, GW, gates);
                hipLaunchKernelGGL(k_wconv<2>, dim3(512), dim3(256), 0, stream, w_in + (size_t)l * D * NIN, D, NIN, NU, nw + 2 * D, WIN);
                hipLaunchKernelGGL(k_wconv<0>, dim3(512), dim3(256), 0, stream, w_out + (size_t)l * D * D, D, D, D, (const float*)nullptr, WOUT);
                launch_gemm(0, XN, WIN, U, NU, D, NU, stream);
                hipLaunchKernelGGL(k_conv, dim3((M * 512) / 256), dim3(256), 0, stream, U, conv_w + (size_t)l * 4 * 512, conv_b + (size_t)l * 512, QKC);
                hipLaunchKernelGGL(k_mlstm_naive, dim3(32), dim3(256), 0, stream, QKC, U, gates, igb + l * 4, fgb + l * 4, mnw + l * 256, Y);
                hipLaunchKernelGGL(k_hgrn_naive, dim3(32), dim3(256), 0, stream, U, lbl, l, hnw + l * 256, Y);
                hipLaunchKernelGGL(k_attn_naive, dim3(4096), dim3(256), 0, stream, U, dlam + l * 256, l, dnw + l * 512, relb, Y);
                launch_gemm(0, Y, WOUT, HOUT, D, D, D, stream);
                hipLaunchKernelGGL((k_thin<1, false>), dim3(256), dim3(512), 0, stream, (const float*)nullptr, out, HOUT, nw + 3 * D, 1.0f, XN, (const float*)nullptr, (float*)nullptr);
            } else {
                hipLaunchKernelGGL((k_thin<1, false>), dim3(256), dim3(512), 0, stream, (const float*)nullptr, out, HOUT, nw + 5 * D, 0.5f, XN, (const float*)nullptr, (float*)nullptr);
            }
        }
    }
}
```

```cpp
#include <hip/hip_runtime.h>
#include <cstdio>
#include <cstdint>

namespace pg8 {
#define PG8_LAS __attribute__((address_space(3)))
typedef unsigned short bf16_t;
typedef short bf16x8 __attribute__((ext_vector_type(8)));
typedef float f32x4 __attribute__((ext_vector_type(4)));
typedef unsigned u32x4 __attribute__((ext_vector_type(4)));
constexpr int BM = 256, BK = 64, HALF = 128, HTB = HALF * BK * 2  , STAGE_BYTES = 8 * HTB, NXCD = 8, WGM = 8;

__host__ __device__ __forceinline__ int lds_byte(int r, int c) { const int st = (r >> 4) * 2 + (c >> 5), rr = r & 15, cc = c & 31, ob = rr * 64 + cc * 2; return st * 1024 + (ob ^ (((ob >> 9) & 1) << 5)); }
__host__ __device__ __forceinline__ void stage_rc(int b, int& R, int& C) { const int st = b / 1024, sb = b % 1024, swz = sb ^ (((sb >> 9) & 1) << 5); R = (st >> 1) * 16 + swz / 64; C = (st & 1) * 32 + (swz % 64) / 2; }
__host__ __device__ __forceinline__ int perm32(int rho) { const int n = rho >> 4, i = rho & 15; return 8 * (i >> 2) + 4 * n + (i & 3); }

struct Unit { int pm, pn; };
struct Gemm { const bf16_t* A; const bf16_t* Bt; int M, N, K; };

struct StaticOrder {
    int nM, nN, nwg, G, c;
    __host__ __device__ void init(int M, int N, int G_, int c_) { nM = M / BM; nN = N / BM; nwg = nM * nN; G = G_; c = c_; }
    __host__ __device__ bool next(int i, Unit& u) const {
        const long L = (long)i * G + c; if (L >= nwg) return false;
        int wgid = (int)L; { const int q = nwg / NXCD, r = nwg % NXCD, xcd = wgid % NXCD, off = wgid / NXCD; wgid = (xcd < r ? xcd * (q + 1) : r * (q + 1) + (xcd - r) * q) + off; }
        const int nig = WGM * nN, gid = wgid / nig, fm = gid * WGM, gsz = (nM - fm) < WGM ? (nM - fm) : WGM;
        u.pm = fm + ((wgid % nig) % gsz); u.pn = (wgid % nig) / gsz; return true;
    }
    __device__ __forceinline__ void a_ready(const Unit&) const {}
    __device__ __forceinline__ void done(const Unit&) const {}
};

__device__ __forceinline__ unsigned cvt_pk_bf16(float lo, float hi) { unsigned r; asm volatile("v_cvt_pk_bf16_f32 %0, %1, %2" : "=v"(r) : "v"(lo), "v"(hi)); return r; }
typedef float f32x2 __attribute__((ext_vector_type(2)));
template <bool RS> struct EpiBf16T {
    static constexpr bool PERM = true, AFTER_DRAIN = false;
    bf16_t* O; int ldc; const float* rs; int ct_lo, ct_hi; float ct_scale;
    __device__ __forceinline__ void prefetch(float (&pre)[8], const Unit& u, int wr, int fr) const {
        if (RS) { const int row0 = u.pm * BM + wr * 64 + fr;
#pragma unroll
            for (int ai = 0; ai < 2; ++ai)
#pragma unroll
                for (int m = 0; m < 4; ++m) pre[ai * 4 + m] = rs[row0 + ai * HALF + m * 16]; } }
    __device__ __forceinline__ void operator()(const f32x4 (&acc)[2][2][4][2], const Unit& u, int wr, int wc, int fr, int fq, const float (&pre)[8]) const {
        const int row0 = u.pm * BM + wr * 64 + fr; const int col0 = u.pn * BM + wc * 32 + 8 * fq;
        float scv[2][4];
#pragma unroll
        for (int ai = 0; ai < 2; ++ai)
#pragma unroll
            for (int m = 0; m < 4; ++m) scv[ai][m] = (RS ? pre[ai * 4 + m] : 1.0f) * ((u.pn >= ct_lo && u.pn < ct_hi) ? ct_scale : 1.0f);
#pragma unroll
        for (int ai = 0; ai < 2; ++ai)
#pragma unroll
            for (int m = 0; m < 4; ++m) { bf16_t* rowp = O + (size_t)(row0 + ai * HALF + m * 16) * ldc + col0; const float sc = scv[ai][m];
#pragma unroll
                for (int bj = 0; bj < 2; ++bj) { const f32x4 v0 = acc[ai][bj][m][0] * sc, v1 = acc[ai][bj][m][1] * sc;
                    u32x4 w; w.x = cvt_pk_bf16(v0[0], v0[1]); w.y = cvt_pk_bf16(v0[2], v0[3]); w.z = cvt_pk_bf16(v1[0], v1[1]); w.w = cvt_pk_bf16(v1[2], v1[3]);
                    *(u32x4*)(rowp + bj * HALF) = w; } }
    }
};
typedef EpiBf16T<false> EpiBf16; typedef EpiBf16T<true> EpiBf16RS;
__device__ __forceinline__ float silu_f(float g) { return g * __builtin_amdgcn_rcpf(1.0f + __expf(-g)); }
typedef float f32x2e __attribute__((ext_vector_type(2))); typedef __bf16 bf16x2e __attribute__((ext_vector_type(2)));
struct EpiSwiGLU {
    static constexpr bool PERM = true, AFTER_DRAIN = false;
    bf16_t* O; int ldc; const float* rs;
    __device__ __forceinline__ void prefetch(float (&pre)[8], const Unit& u, int wr, int fr) const {
        const int row0 = u.pm * BM + wr * 64 + fr;
#pragma unroll
        for (int ai = 0; ai < 2; ++ai)
#pragma unroll
            for (int m = 0; m < 4; ++m) pre[ai * 4 + m] = rs[row0 + ai * HALF + m * 16]; }
    __device__ __forceinline__ void operator()(const f32x4 (&acc)[2][2][4][2], const Unit& u, int wr, int wc, int fr, int fq, const float (&pre)[8]) const {
        const int row0 = u.pm * BM + wr * 64 + fr; const int col0 = u.pn * HALF + wc * 32 + 8 * fq;
        float scv[2][4];
#pragma unroll
        for (int ai = 0; ai < 2; ++ai)
#pragma unroll
            for (int m = 0; m < 4; ++m) scv[ai][m] = pre[ai * 4 + m];
#pragma unroll
        for (int ai = 0; ai < 2; ++ai)
#pragma unroll
            for (int m = 0; m < 4; ++m) { bf16_t* rowp = O + (size_t)(row0 + ai * HALF + m * 16) * ldc + col0;
                const float sc = scv[ai][m], sl = -1.4426950408889634f * sc, s2 = sc * sc;
                unsigned wv_[4];
#pragma unroll
                for (int q = 0; q < 2; ++q)
#pragma unroll
                    for (int p = 0; p < 2; ++p) { const f32x4 gq = acc[ai][0][m][q], uq = acc[ai][1][m][q];
                        const f32x2e g = {gq[2 * p], gq[2 * p + 1]}, uu = {uq[2 * p], uq[2 * p + 1]};
                        const f32x2e t = g * sl; f32x2e ex = {__builtin_amdgcn_exp2f(t.x), __builtin_amdgcn_exp2f(t.y)}; ex = ex + 1.0f;
                        const f32x2e r = {__builtin_amdgcn_rcpf(ex.x), __builtin_amdgcn_rcpf(ex.y)};
                        const f32x2e o = ((g * uu) * s2) * r;
                        wv_[2 * q + p] = __builtin_bit_cast(unsigned, __builtin_convertvector(o, bf16x2e)); }
                u32x4 w; w.x = wv_[0]; w.y = wv_[1]; w.z = wv_[2]; w.w = wv_[3];
                *(u32x4*)rowp = w; }
    }
};
template <class Epi, class Sched, bool ALIGN_EPI = false, bool SP2 = false>
__device__ __forceinline__ void gemm_phase(PG8_LAS unsigned char* lds, const Gemm g, const Sched& S, const Epi& E, int tid_in) {
    int tid_ = tid_in; asm volatile("" : "+v"(tid_));
    const int tid = tid_, wid = __builtin_amdgcn_readfirstlane(tid >> 6), lane = tid & 63, wr = wid >> 2, wc = wid & 3, fr = lane & 15, fq = lane >> 4;
    const int K = g.K, nt = K / BK;
    unsigned voffA[2], voffB[2];
#pragma unroll
    for (int i = 0; i < 2; ++i) { int R, C; stage_rc(tid * 16 + i * 8192, R, C); const int Rb = Epi::PERM ? ((R & ~31) + perm32(R & 31)) : R;
        voffA[i] = (unsigned)(R * K + C) * 2u; voffB[i] = (unsigned)(Rb * K + C) * 2u; }
    const size_t kstep = (size_t)(BK * 2);
    const size_t hstep = (size_t)HALF * K * 2;
    const size_t tstep = 2 * hstep;
    const unsigned ldsw = (unsigned)wid * 1024u;
    const int aoff = lds_byte(wr * 64 + fr, fq * 8), boff = lds_byte(wc * 32 + fr, fq * 8);
#define PG8_SA(b, h) (((b) * 2 + (h)) * HTB)
#define PG8_SB(b, h) ((4 + (b) * 2 + (h)) * HTB)
#define PG8_STAGE(bufoff, gbase, voff) do { _Pragma("unroll") for (int _i = 0; _i < 2; ++_i) \
        __builtin_amdgcn_global_load_lds((const unsigned*)((const char*)(gbase) + (voff)[_i]), (PG8_LAS unsigned*)(lds + (bufoff) + ldsw + _i * 8192), 16, 0, 0); } while (0)
#define PG8_LDA(dst, b, h) do { _Pragma("unroll") for (int m = 0; m < 4; ++m) _Pragma("unroll") for (int k = 0; k < 2; ++k) dst[m][k] = *(const PG8_LAS bf16x8*)(lds + PG8_SA(b, h) + aoff + m * 2048 + k * 1024); } while (0)
#define PG8_LDB(dst, b, h) do { _Pragma("unroll") for (int n = 0; n < 2; ++n) _Pragma("unroll") for (int k = 0; k < 2; ++k) dst[n][k] = *(const PG8_LAS bf16x8*)(lds + PG8_SB(b, h) + boff + n * 2048 + k * 1024); } while (0)
#define PG8_MMA(ai, bj, At, Bt) do { __builtin_amdgcn_s_setprio(1); _Pragma("unroll") for (int m = 0; m < 4; ++m) _Pragma("unroll") for (int n = 0; n < 2; ++n) _Pragma("unroll") for (int k = 0; k < 2; ++k) \
        acc[ai][bj][m][n] = __builtin_amdgcn_mfma_f32_16x16x32_bf16(Bt[n][k], At[m][k], acc[ai][bj][m][n], 0, 0, 0); __builtin_amdgcn_s_setprio(0); } while (0)
#define PG8_WAIT_V(n) asm volatile("s_waitcnt vmcnt(" #n ")" ::: "memory")
#define PG8_WAIT_L(n) asm volatile("s_waitcnt lgkmcnt(" #n ")" ::: "memory")
#define PG8_BAR __builtin_amdgcn_s_barrier()
#define PG8_SCHED __builtin_amdgcn_sched_barrier(0)
    Unit cur, nxt; int ui = 0;
    float epre[8];
#pragma unroll
    for (int i = 0; i < 8; ++i) epre[i] = 1.0f;
    if (!S.next(0, cur)) return;
    f32x4 acc[2][2][4][2];
#pragma unroll
    for (int a = 0; a < 2; ++a)
#pragma unroll
        for (int b = 0; b < 2; ++b)
#pragma unroll
            for (int m = 0; m < 4; ++m)
#pragma unroll
                for (int n = 0; n < 2; ++n) acc[a][b][m][n] = (f32x4){0.f, 0.f, 0.f, 0.f};
    bf16x8 At[4][2], B0[2][2], B1[2][2];
    const char* cA = (const char*)g.A + (size_t)cur.pm * tstep; const char* cB = (const char*)g.Bt + (size_t)cur.pn * tstep;
    S.a_ready(cur);
    if constexpr (SP2) {
        PG8_STAGE(PG8_SB(0, 0), cB, voffB); PG8_STAGE(PG8_SB(0, 1), cB + hstep, voffB); PG8_STAGE(PG8_SA(0, 0), cA, voffA); PG8_STAGE(PG8_SA(0, 1), cA + hstep, voffA);
        if (wr == 1) PG8_BAR;
        PG8_WAIT_V(2); PG8_BAR;
        PG8_STAGE(PG8_SB(1, 0), cB + kstep, voffB); PG8_STAGE(PG8_SA(1, 0), cA + kstep, voffA); PG8_STAGE(PG8_SB(1, 1), cB + hstep + kstep, voffB);
        PG8_WAIT_V(6); PG8_BAR;
    } else {
        PG8_STAGE(PG8_SB(0, 0), cB, voffB); PG8_STAGE(PG8_SA(0, 0), cA, voffA); PG8_STAGE(PG8_SB(0, 1), cB + hstep, voffB); PG8_STAGE(PG8_SA(0, 1), cA + hstep, voffA);
        if (wr == 1) PG8_BAR;
        PG8_WAIT_V(4); PG8_BAR;
        PG8_STAGE(PG8_SB(1, 0), cB + kstep, voffB); PG8_STAGE(PG8_SA(1, 0), cA + kstep, voffA); PG8_STAGE(PG8_SB(1, 1), cB + hstep + kstep, voffB);
        PG8_WAIT_V(6); PG8_BAR;
    }
    for (;;) {
        const bool has_next = S.next(ui + 1, nxt);
        const char* nA = has_next ? (const char*)g.A + (size_t)nxt.pm * tstep : cA; const char* nB = has_next ? (const char*)g.Bt + (size_t)nxt.pn * tstep : cB;
        for (int t = 0; t < nt; t += 2) {
            const bool last = (t == nt - 2);
            const char* a1 = cA + (size_t)(t + 1) * kstep;
            const char* a2 = last ? nA : cA + (size_t)(t + 2) * kstep; const char* b2 = last ? nB : cB + (size_t)(t + 2) * kstep;
            const char* a3 = a2 + kstep; const char* b3 = b2 + kstep;
            if (last && has_next) S.a_ready(nxt);
            if (last) E.prefetch(epre, cur, wr, fr);
            if constexpr (SP2) {
            PG8_LDB(B0, 0, 0); PG8_LDB(B1, 0, 1); PG8_SCHED; PG8_LDA(At, 0, 0); PG8_STAGE(PG8_SA(1, 1), a1 + hstep, voffA);
            PG8_WAIT_V(8); PG8_WAIT_L(0); PG8_BAR; PG8_MMA(0, 0, At, B0); PG8_MMA(0, 1, At, B1); PG8_BAR; PG8_SCHED;
            PG8_LDA(At, 0, 1); PG8_STAGE(PG8_SB(0, 0), b2, voffB); PG8_STAGE(PG8_SB(0, 1), b2 + hstep, voffB); PG8_STAGE(PG8_SA(0, 0), a2, voffA);
            PG8_WAIT_V(8); PG8_WAIT_L(0); PG8_BAR; PG8_MMA(1, 0, At, B0); PG8_MMA(1, 1, At, B1); PG8_BAR; PG8_SCHED;
            PG8_LDB(B0, 1, 0); PG8_LDB(B1, 1, 1); PG8_SCHED; PG8_LDA(At, 1, 0); PG8_STAGE(PG8_SA(0, 1), a2 + hstep, voffA);
            PG8_WAIT_V(8); PG8_WAIT_L(0); PG8_BAR; PG8_MMA(0, 0, At, B0); PG8_MMA(0, 1, At, B1); PG8_BAR; PG8_SCHED;
            PG8_LDA(At, 1, 1); PG8_STAGE(PG8_SB(1, 0), b3, voffB); PG8_STAGE(PG8_SB(1, 1), b3 + hstep, voffB); PG8_STAGE(PG8_SA(1, 0), a3, voffA);
            PG8_WAIT_V(8); PG8_WAIT_L(0); PG8_BAR; PG8_MMA(1, 0, At, B0); PG8_MMA(1, 1, At, B1); PG8_BAR; PG8_SCHED;
            } else {
            PG8_LDB(B0, 0, 0); PG8_SCHED; PG8_LDA(At, 0, 0); PG8_STAGE(PG8_SA(1, 1), a1 + hstep, voffA);
            PG8_WAIT_L(8); PG8_BAR; PG8_WAIT_L(0); PG8_MMA(0, 0, At, B0); PG8_BAR; PG8_SCHED;
            PG8_LDB(B1, 0, 1); PG8_STAGE(PG8_SB(0, 0), b2, voffB);
            PG8_BAR; PG8_WAIT_L(0); PG8_MMA(0, 1, At, B1); PG8_BAR;
            PG8_LDA(At, 0, 1); PG8_STAGE(PG8_SA(0, 0), a2, voffA);
            PG8_BAR; PG8_WAIT_L(0); PG8_MMA(1, 0, At, B0); PG8_BAR; PG8_SCHED;
            PG8_STAGE(PG8_SB(0, 1), b2 + hstep, voffB);
            PG8_WAIT_V(6); PG8_BAR; PG8_MMA(1, 1, At, B1); PG8_BAR;
            PG8_LDB(B0, 1, 0); PG8_SCHED; PG8_LDA(At, 1, 0); PG8_STAGE(PG8_SA(0, 1), a2 + hstep, voffA);
            PG8_WAIT_L(8); PG8_BAR; PG8_WAIT_L(0); PG8_MMA(0, 0, At, B0); PG8_BAR; PG8_SCHED;
            PG8_LDB(B1, 1, 1); PG8_STAGE(PG8_SB(1, 0), b3, voffB);
            PG8_BAR; PG8_WAIT_L(0); PG8_MMA(0, 1, At, B1); PG8_BAR;
            PG8_LDA(At, 1, 1); PG8_STAGE(PG8_SA(1, 0), a3, voffA);
            PG8_BAR; PG8_WAIT_L(0); PG8_MMA(1, 0, At, B0); PG8_BAR; PG8_SCHED;
            PG8_STAGE(PG8_SB(1, 1), b3 + hstep, voffB);
            PG8_WAIT_V(6); PG8_BAR; PG8_MMA(1, 1, At, B1); PG8_BAR;
            }
        }
        if constexpr (ALIGN_EPI) { if (wr == 0) PG8_BAR; }
        if constexpr (!Epi::AFTER_DRAIN) { E(acc, cur, wr, wc, fr, fq, epre); S.done(cur); }
        if (!has_next) break;
#pragma unroll
        for (int a = 0; a < 2; ++a)
#pragma unroll
            for (int b = 0; b < 2; ++b)
#pragma unroll
                for (int m = 0; m < 4; ++m)
#pragma unroll
                    for (int n = 0; n < 2; ++n) acc[a][b][m][n] = (f32x4){0.f, 0.f, 0.f, 0.f};
        cur = nxt; cA = nA; cB = nB; ++ui;
        if constexpr (ALIGN_EPI) { if (wr == 1) PG8_BAR; }
    }
    PG8_WAIT_V(0);
    if constexpr (!ALIGN_EPI) { if (wr == 0) PG8_BAR; }
    PG8_BAR;
    if constexpr (Epi::AFTER_DRAIN) { E.fused(acc, cur, wr, wc, fr, fq, lds, wid, lane); S.done(cur); }
#undef PG8_SA
#undef PG8_SB
#undef PG8_STAGE
#undef PG8_LDA
#undef PG8_LDB
#undef PG8_MMA
#undef PG8_WAIT_V
#undef PG8_WAIT_L
#undef PG8_BAR
#undef PG8_SCHED
}
}
constexpr int NB = 8, S = 4096, D = 1024, M = NB * S, DEPTH = 4, FF = 2816, NU = 3584, NIN = 3592;
constexpr float EPS = 1e-6f;
constexpr int U_QKM = 0, U_VM = 512, U_OM = 768, U_QD = 1024, U_KD = 1536, U_VD = 2048, U_QH = 2560, U_FH = 2816, U_IH = 3072, U_GH = 3328;
constexpr int Y_M = 0, Y_D = 256, Y_H = 768;
typedef unsigned short bf16;
typedef float f32x4 __attribute__((ext_vector_type(4)));
typedef unsigned v4u __attribute__((ext_vector_type(4)));
typedef unsigned v2u __attribute__((ext_vector_type(2)));
#define LAS __attribute__((address_space(3)))
#define LDS_WAIT() asm volatile("s_waitcnt lgkmcnt(0)" ::: "memory")

constexpr size_t MiB = 1u << 20;
constexpr size_t WS_CTL = 0, WS_GW = 1 * MiB, WS_WI = 2 * MiB, WS_WO = 14 * MiB, WS_WIN = 20 * MiB, WS_WOUT = 28 * MiB, WS_GATES = 30 * MiB, WS_RS = 31 * MiB;
constexpr size_t WS_XN = 32 * MiB, WS_U = 96 * MiB, WS_HOUT = 320 * MiB, WS_Y = 384 * MiB, WS_MIX = 448 * MiB, WS_END = 504 * MiB;

__device__ __forceinline__ float bf2f(unsigned v) { return __uint_as_float(v << 16); }
__device__ __forceinline__ unsigned f2bf(float f) { unsigned u = __float_as_uint(f); return (u + 0x7fffu + ((u >> 16) & 1u)) >> 16; }
typedef float f32x2c_t __attribute__((ext_vector_type(2))); typedef __bf16 bf16x2c_t __attribute__((ext_vector_type(2)));
__device__ __forceinline__ unsigned pk2(float lo, float hi) { f32x2c_t v = {lo, hi}; bf16x2c_t b = __builtin_convertvector(v, bf16x2c_t); return __builtin_bit_cast(unsigned, b); }
__device__ __forceinline__ int lane_id_now() { int l; asm volatile("v_mbcnt_lo_u32_b32 %0, -1, 0\n\tv_mbcnt_hi_u32_b32 %0, -1, %0" : "=v"(l)); return l; }
__device__ __forceinline__ float shx(float v, int o, int lane) { return __int_as_float(__builtin_amdgcn_ds_bpermute((lane ^ o) << 2, __float_as_int(v))); }
__device__ __forceinline__ float shl_from(float v, int src_lane) { return __int_as_float(__builtin_amdgcn_ds_bpermute(src_lane << 2, __float_as_int(v))); }
__device__ __forceinline__ float wave_sum(float v, int lane) {
#pragma unroll
    for (int o = 1; o < 64; o <<= 1) v += shx(v, o, lane);
    return v;
}
__device__ __forceinline__ float sigmoid_f(float x) { return 1.0f / (1.0f + expf(-x)); }

template <int KIND> __device__ __forceinline__ int srccol(int n) {
    if (KIND == 1) { const int pn = n >> 8, j = n & 255; return j < 128 ? 128 * pn + j : FF + 128 * pn + (j - 128); }
    if (KIND == 2) return n < 1024 ? n : n + 8;
    return n;
}
template <int KIND> __device__ __forceinline__ void wconv_items(const float* W, int K, int Nsrc, int N, const float* nw, bf16* Bt, LAS float* scr, int gw, int NGW, int lane) {
    const int nblk = N / 32, nitems = (K / 64) * nblk;
    for (int it0 = gw; it0 < nitems; it0 += 2 * NGW) {
        const int it1 = it0 + NGW; const bool two = it1 < nitems;
        float wv[2][32]; int k0s[2], n0s[2];
#pragma unroll
        for (int q = 0; q < 2; ++q) { const int it = q == 0 ? it0 : (two ? it1 : it0); const int kb = it / nblk, nb = it % nblk, k0 = 64 * kb, n0 = 32 * nb, sc0 = srccol<KIND>(n0); k0s[q] = k0; n0s[q] = n0;
            if (q == 0 || two) {
#pragma unroll
                for (int i = 0; i < 32; ++i) { const int kk = 2 * i + (lane >> 5); wv[q][i] = __builtin_nontemporal_load(&W[(size_t)(k0 + kk) * Nsrc + sc0 + (lane & 31)]); }
            } else {
#pragma unroll
                for (int i = 0; i < 32; ++i) wv[q][i] = 0.f; } }
#pragma unroll
        for (int q = 0; q < 2; ++q) { if (q == 1 && !two) break; const int k0 = k0s[q], n0 = n0s[q];
            if (nw) { const float nwv = nw[k0 + lane];
#pragma unroll
                for (int i = 0; i < 32; ++i) { const float a = __int_as_float(__builtin_amdgcn_readlane(__float_as_int(nwv), 2 * i)), b2 = __int_as_float(__builtin_amdgcn_readlane(__float_as_int(nwv), 2 * i + 1)); wv[q][i] *= (lane < 32) ? a : b2; } }
#pragma unroll
            for (int i = 0; i < 32; ++i) scr[(2 * i + (lane >> 5)) * 33 + (lane & 31)] = wv[q][i];
            LDS_WAIT();
            const int c = lane & 7;
#pragma unroll
            for (int j = 0; j < 4; ++j) { const int n = (lane >> 3) + 8 * j; const LAS float* s = scr + (8 * c) * 33 + n;
                v4u o; o.x = pk2(s[0 * 33], s[1 * 33]); o.y = pk2(s[2 * 33], s[3 * 33]); o.z = pk2(s[4 * 33], s[5 * 33]); o.w = pk2(s[6 * 33], s[7 * 33]);
                *(v4u*)(Bt + (size_t)(n0 + n) * K + k0 + 8 * c) = o; }
            LDS_WAIT(); }
    }
}
template <int MODE, bool GATES, bool LAST> __device__ __forceinline__ void thin_rows(const float* xin, bf16* xb, const bf16* h, const float* wa, float c, float* rs, float* outf, const LAS float* gwl, float* gates, int gw, int NGW, int lane, bool contig  ) {
    constexpr int R = GATES ? 2 : 4;
    f32x4 wav[4];
    if (MODE == 1) {
#pragma unroll
        for (int j = 0; j < 4; ++j) wav[j] = *(const f32x4*)(wa + 4 * lane + 256 * j);
    }
    const int rpw = M / NGW;
    for (int mb = contig ? gw * rpw : gw * R, me = contig ? gw * rpw + rpw : M; mb < me; mb += contig ? R : NGW * R) {
        f32x4 xv[R][4]; v2u xr[R][4], hr[R][4];
#pragma unroll
        for (int i = 0; i < R; ++i) {
            if (MODE == 0) {
#pragma unroll
                for (int j = 0; j < 4; ++j) xv[i][j] = __builtin_nontemporal_load((const f32x4*)(xin + (size_t)(mb + i) * D + 4 * lane + 256 * j));
            } else {
#pragma unroll
                for (int j = 0; j < 4; ++j) { xr[i][j] = *(const v2u*)(xb + (size_t)(mb + i) * D + 4 * lane + 256 * j);
                    hr[i][j] = __builtin_nontemporal_load((const v2u*)(h + (size_t)(mb + i) * D + 4 * lane + 256 * j)); }
            } }
        float rx[R]; f32x4 hv[R][4];
        if (MODE == 1) { float ss[R];
#pragma unroll
            for (int i = 0; i < R; ++i) { ss[i] = 0.f;
#pragma unroll
                for (int j = 0; j < 4; ++j) { const v2u t = hr[i][j], q = xr[i][j];
                    hv[i][j].x = bf2f(t.x & 0xffffu); hv[i][j].y = bf2f(t.x >> 16); hv[i][j].z = bf2f(t.y & 0xffffu); hv[i][j].w = bf2f(t.y >> 16);
                    xv[i][j].x = bf2f(q.x & 0xffffu); xv[i][j].y = bf2f(q.x >> 16); xv[i][j].z = bf2f(q.y & 0xffffu); xv[i][j].w = bf2f(q.y >> 16);
                    ss[i] += (hv[i][j].x * hv[i][j].x + hv[i][j].y * hv[i][j].y) + (hv[i][j].z * hv[i][j].z + hv[i][j].w * hv[i][j].w); } }
#pragma unroll
            for (int o = 1; o < 64; o <<= 1) { float t[R];
#pragma unroll
                for (int i = 0; i < R; ++i) t[i] = shx(ss[i], o, lane);
#pragma unroll
                for (int i = 0; i < R; ++i) ss[i] += t[i]; }
#pragma unroll
            for (int i = 0; i < R; ++i) { const float rh = c * __builtin_amdgcn_rsqf(ss[i] * (1.0f / D) + EPS);
#pragma unroll
                for (int j = 0; j < 4; ++j) xv[i][j] = xv[i][j] + hv[i][j] * wav[j] * rh; }
        }
#pragma unroll
        for (int i = 0; i < R; ++i) rx[i] = 0.f;
        if (LAST) {
#pragma unroll
            for (int i = 0; i < R; ++i)
#pragma unroll
                for (int j = 0; j < 4; ++j) __builtin_nontemporal_store(xv[i][j], (f32x4*)(outf + (size_t)(mb + i) * D + 4 * lane + 256 * j));
        } else { float s2[R];
#pragma unroll
            for (int i = 0; i < R; ++i) { s2[i] = 0.f;
#pragma unroll
                for (int j = 0; j < 4; ++j) s2[i] += (xv[i][j].x * xv[i][j].x + xv[i][j].y * xv[i][j].y) + (xv[i][j].z * xv[i][j].z + xv[i][j].w * xv[i][j].w); }
#pragma unroll
            for (int o = 1; o < 64; o <<= 1) { float t[R];
#pragma unroll
                for (int i = 0; i < R; ++i) t[i] = shx(s2[i], o, lane);
#pragma unroll
                for (int i = 0; i < R; ++i) s2[i] += t[i]; }
            float rxl = 0.f;
#pragma unroll
            for (int i = 0; i < R; ++i) { rx[i] = __builtin_amdgcn_rsqf(s2[i] * (1.0f / D) + EPS); rxl = lane == i ? rx[i] : rxl; }
            if (lane < R) rs[mb + lane] = rxl;
#pragma unroll
            for (int i = 0; i < R; ++i)
#pragma unroll
                for (int j = 0; j < 4; ++j) { v2u o; o.x = pk2(xv[i][j].x, xv[i][j].y); o.y = pk2(xv[i][j].z, xv[i][j].w);
                    *(v2u*)(xb + (size_t)(mb + i) * D + 4 * lane + 256 * j) = o; }
        }
        if (GATES) {
            float v[16];
#pragma unroll
            for (int jg = 0; jg < 8; ++jg) { float p[R];
#pragma unroll
                for (int i = 0; i < R; ++i) p[i] = 0.f;
#pragma unroll
                for (int j = 0; j < 4; ++j) { const f32x4 t = *(const LAS f32x4*)(gwl + jg * D + 4 * lane + 256 * j);
#pragma unroll
                    for (int i = 0; i < R; ++i) p[i] += (xv[i][j].x * t.x + xv[i][j].y * t.y) + (xv[i][j].z * t.z + xv[i][j].w * t.w); }
#pragma unroll
                for (int i = 0; i < R; ++i) v[(i & 1) * 8 + jg] = p[i]; }
            const bool b5 = (lane >> 5) & 1, b4 = (lane >> 4) & 1, b3 = (lane >> 3) & 1, b2 = (lane >> 2) & 1;
            float w[8], x4[4], y2[2];
#pragma unroll
            for (int k = 0; k < 8; ++k) w[k] = (b5 ? v[8 + k] : v[k]) + shx(b5 ? v[k] : v[8 + k], 32, lane);
#pragma unroll
            for (int k = 0; k < 4; ++k) x4[k] = (b4 ? w[4 + k] : w[k]) + shx(b4 ? w[k] : w[4 + k], 16, lane);
#pragma unroll
            for (int k = 0; k < 2; ++k) y2[k] = (b3 ? x4[2 + k] : x4[k]) + shx(b3 ? x4[k] : x4[2 + k], 8, lane);
            float z = (b2 ? y2[1] : y2[0]) + shx(b2 ? y2[0] : y2[1], 4, lane);
            z += shx(z, 2, lane); z += shx(z, 1, lane);
            if ((lane & 3) == 0) gates[(size_t)(mb + (b5 ? 1 : 0)) * 8 + 4 * (b4 ? 1 : 0) + 2 * (b3 ? 1 : 0) + (b2 ? 1 : 0)] = z * (b5 ? rx[1 % R] : rx[0]);
        }
    }
}
#define XB_TMO      128
#define XB_XCNT(j)  (256  + 64 * (j))
#define XB_XSUB(j)  (1280 + 64 * (j))
#define XB_XGEN(j)  (2304 + 64 * (j))
#define XB_TOP      3328
#define XB_TOPGEN   3392
#define XCD_BAR_WORDS 3456
#define XB_SPIN_CAP (1u << 18)

__device__ __forceinline__ unsigned xb_ld(unsigned* p)              { return __hip_atomic_load(p, __ATOMIC_RELAXED, __HIP_MEMORY_SCOPE_AGENT); }
__device__ __forceinline__ unsigned xb_add(unsigned* p, unsigned v) { return __hip_atomic_fetch_add(p, v, __ATOMIC_RELAXED, __HIP_MEMORY_SCOPE_AGENT); }
__device__ __forceinline__ unsigned xb_xcc_id() { return (unsigned)__builtin_amdgcn_s_getreg((3 << 11) | 20) & 0xFu; }
#define XB_SPIN(cond, bar) do { unsigned _sp = 0; while (cond) { __builtin_amdgcn_s_sleep(1); \
    if ((++_sp & 255u) == 0u) { if (xb_ld(&(bar)[XB_TMO])) break; if (_sp > XB_SPIN_CAP) { atomicAdd(&(bar)[XB_TMO], 1u); break; } } } } while (0)

struct XcdBarrier {
    unsigned* bar; unsigned x;
    volatile LAS unsigned* st;
};

__device__ __forceinline__ XcdBarrier xcd_barrier_post(unsigned* bar, volatile LAS unsigned* st, int tid) {
    XcdBarrier b; b.bar = bar; b.x = xb_xcc_id(); b.st = st;
    if (tid == 0) (void)xb_add(&bar[XB_XCNT(b.x)], 1u);
    return b;
}
__device__ __forceinline__ void xcd_barrier_complete(unsigned* bar, unsigned x, unsigned& nloc, unsigned& nx) {
    const unsigned G = gridDim.x * gridDim.y * gridDim.z;
    unsigned sum, cnt, mine, sp = 0u;
    for (;;) {
        sum = 0u; cnt = 0u; mine = 0u;
#pragma unroll
        for (unsigned j = 0; j < 16; ++j) { const unsigned c = xb_ld(&bar[XB_XCNT(j)]); sum += c; cnt += (c > 0u) ? 1u : 0u; mine = (j == x) ? c : mine; }
        if (sum == G) break;
        __builtin_amdgcn_s_sleep(1);
        if ((++sp & 255u) == 0u) { if (xb_ld(&bar[XB_TMO])) break; if (sp > XB_SPIN_CAP) { atomicAdd(&bar[XB_TMO], 1u); break; } }
    }
    nloc = mine > 0u ? mine : 1u; nx = cnt > 0u ? cnt : 1u;
}

__device__ __forceinline__ void xcd_barrier(const XcdBarrier& b, int tid) {
    asm volatile("s_waitcnt vmcnt(0)" ::: "memory");
    __syncthreads();
    if (tid == 0) {
        unsigned* bar = b.bar;
        __builtin_amdgcn_s_waitcnt(0);
        unsigned nloc = b.st[0], nx = b.st[1];
        if (nloc == 0u) { xcd_barrier_complete(bar, b.x, nloc, nx); b.st[0] = nloc; b.st[1] = nx; }
        const unsigned old = xb_add(&bar[XB_XSUB(b.x)], 1u);
        const unsigned gen = old / nloc;
        if (old + 1u == (gen + 1u) * nloc) {
            __builtin_amdgcn_fence(__ATOMIC_RELEASE, "agent");
            asm volatile("s_waitcnt vmcnt(0)" ::: "memory");
            const unsigned og = xb_add(&bar[XB_TOP], 1u);
            const unsigned tg = og / nx;
            if (og + 1u == (tg + 1u) * nx) xb_add(&bar[XB_TOPGEN], 1u);
            else XB_SPIN(xb_ld(&bar[XB_TOPGEN]) == tg, bar);
            __builtin_amdgcn_fence(__ATOMIC_ACQUIRE, "agent");
            xb_add(&bar[XB_XGEN(b.x)], 1u);
            asm volatile("s_waitcnt vmcnt(0)" ::: "memory");
        } else {
            XB_SPIN(xb_ld(&bar[XB_XGEN(b.x)]) == gen, bar);
            __builtin_amdgcn_fence(__ATOMIC_ACQUIRE, "agent");
            asm volatile("s_waitcnt vmcnt(0)" ::: "memory");
        }
    }
    __syncthreads();
}

#define GB_X(g, x)  (8192 + 64 * (g) + (x))
#define GB_CNT(g)   (8192 + 512 + 64 * (g))
#define GB_GEN(g)   (8192 + 1024 + 64 * (g))
__device__ __forceinline__ void grp_post(unsigned* ctl, int bx, int tid) { if (tid == 0) (void)xb_add(&ctl[GB_X(bx & 7, xb_xcc_id())], 1u); }
__device__ __forceinline__ void grp_barrier(unsigned* ctl, unsigned* bar, int bx, int G, volatile LAS unsigned* st, int tid) {
    asm volatile("s_waitcnt vmcnt(0)" ::: "memory");
    __syncthreads();
    if (tid == 0) {
        const unsigned g = (unsigned)bx & 7u, ng = (unsigned)G >> 3;
        unsigned mode = st[0];
        if (mode == 0u) { const unsigned x = xb_xcc_id(); unsigned sum, mine, sp = 0u;
            for (;;) { sum = 0u; mine = 0u;
#pragma unroll
                for (unsigned j = 0; j < 16; ++j) { const unsigned c = xb_ld(&ctl[GB_X(g, j)]); sum += c; mine = (j == x) ? c : mine; }
                if (sum == ng) break;
                __builtin_amdgcn_s_sleep(1);
                if ((++sp & 255u) == 0u) { if (xb_ld(&bar[XB_TMO])) break; if (sp > XB_SPIN_CAP) { atomicAdd(&bar[XB_TMO], 1u); break; } } }
            mode = (sum == ng && mine == ng) ? 1u : 2u; st[0] = mode; }
        if (mode != 1u) { __builtin_amdgcn_fence(__ATOMIC_RELEASE, "agent"); asm volatile("s_waitcnt vmcnt(0)" ::: "memory"); }
        const unsigned old = xb_add(&ctl[GB_CNT(g)], 1u), gen = old / ng;
        if (old + 1u == (gen + 1u) * ng) xb_add(&ctl[GB_GEN(g)], 1u);
        else XB_SPIN(xb_ld(&ctl[GB_GEN(g)]) == gen, bar);
        __builtin_amdgcn_fence(__ATOMIC_ACQUIRE, "agent");
        asm volatile("s_waitcnt vmcnt(0)" ::: "memory");
    }
    __syncthreads();
}
__device__ __forceinline__ float silu_acc(float a) { return a / (1.0f + expf(-a)); }
__device__ __forceinline__ float fexp(float v) { return __builtin_amdgcn_exp2f(v * 1.4426950408889634f); }
__device__ __forceinline__ float flog(float v) { return __builtin_amdgcn_logf(v) * 0.6931471805599453f; }
__device__ __forceinline__ float fsigmoid(float v) { return __builtin_amdgcn_rcpf(1.0f + fexp(-v)); }
__device__ __forceinline__ float fsilu(float v) { return v * fsigmoid(v); }
__device__ __forceinline__ float hgrn_lb(const float* lbl, int layer, int c) {
    float l0 = lbl[c], l1 = lbl[256 + c], l2 = lbl[512 + c], l3 = lbl[768 + c];
    const float mx = fmaxf(fmaxf(l0, l1), fmaxf(l2, l3)); l0 = fexp(l0 - mx); l1 = fexp(l1 - mx); l2 = fexp(l2 - mx); l3 = fexp(l3 - mx);
    const float inv = __builtin_amdgcn_rcpf(l0 + l1 + l2 + l3); float lb = 0.f; if (layer >= 1) lb += l1 * inv; if (layer >= 2) lb += l2 * inv; if (layer >= 3) lb += l3 * inv;
    return fmaxf(lb, 0.f);
}
__device__ __forceinline__ int t5_bucket(int n) {
    if (n < 16) return n;
    const int v = 16 + (int)(logf((float)n / 16.0f) / logf(8.0f) * 16.0f); return v < 31 ? v : 31;
}
__device__ __forceinline__ float diff_lambda(const float* lamv, int layer, float& lam_init) {
    float a = 0.f, c = 0.f; for (int d = 0; d < 64; ++d) { a += lamv[d] * lamv[64 + d]; c += lamv[128 + d] * lamv[192 + d]; }
    lam_init = layer == 0 ? 0.2f : (layer == 1 ? 0.35550906759096934f : (layer == 2 ? 0.4707130183435842f : 0.5560582041556406f));
    return expf(a) - expf(c) + lam_init;
}
typedef short bf16x8 __attribute__((ext_vector_type(8)));
typedef short s16x4 __attribute__((ext_vector_type(4)));
typedef float f32x16 __attribute__((ext_vector_type(16)));
typedef float f32x2_t __attribute__((ext_vector_type(2))); typedef __bf16 bf16x2_t __attribute__((ext_vector_type(2)));
__device__ __forceinline__ unsigned cvtpk(float lo, float hi) { f32x2_t v = {lo, hi}; bf16x2_t b = __builtin_convertvector(v, bf16x2_t); return __builtin_bit_cast(unsigned, b); }
__device__ __forceinline__ float xhalf_max(float v) { unsigned a = __builtin_bit_cast(unsigned, v), b = a; asm volatile("s_nop 1\n\tv_permlane32_swap_b32 %0, %1" : "+v"(a), "+v"(b));
    return __builtin_fmaxf(__builtin_bit_cast(float, a), __builtin_bit_cast(float, b)); }
__device__ __forceinline__ float xhalf_sum(float v) { unsigned a = __builtin_bit_cast(unsigned, v), b = a; asm volatile("s_nop 1\n\tv_permlane32_swap_b32 %0, %1" : "+v"(a), "+v"(b));
    return __builtin_bit_cast(float, a) + __builtin_bit_cast(float, b); }
__device__ __forceinline__ int crow(int r, int h) { return (r & 3) + 8 * (r >> 2) + 4 * h; }
__device__ __forceinline__ int swz16(int row) { return ((row & 3) << 2) | ((row >> 2) & 3); }
__device__ __forceinline__ bf16x8 at_vfrag(const LAS unsigned char* base, int o0, int o1) {
    const s16x4 lo = __builtin_bit_cast(s16x4, __builtin_amdgcn_ds_read_tr16_b64_v4i16((LAS s16x4*)(base + o0)));
    const s16x4 hi = __builtin_bit_cast(s16x4, __builtin_amdgcn_ds_read_tr16_b64_v4i16((LAS s16x4*)(base + o1)));
    return __builtin_shufflevector(lo, hi, 0, 1, 2, 3, 4, 5, 6, 7);
}
constexpr int AT_BUF = 32768, AT_VO = 16384, AT_NBUF = 3, AT_BT = AT_NBUF * AT_BUF, AT_LAM = AT_BT + 512;
__device__ __forceinline__ void at_glds16(const void* gsrc, unsigned lds_dst) { unsigned keep;
    asm volatile("s_mov_b32 %0, m0\n\ts_mov_b32 m0, %2\n\ts_nop 0\n\tglobal_load_lds_dwordx4 %1, off\n\ts_mov_b32 m0, %0" : "=&s"(keep) : "v"(gsrc), "s"(lds_dst) : "memory"); }
#define AT_WAIT_BAR(N) asm volatile("s_waitcnt vmcnt(" #N ") lgkmcnt(0)\n\ts_barrier" ::: "memory")
constexpr float L2E = 1.4426950408889634f, C2 = 0.125f * 1.4426950408889634f, AT_THR = 8.0f;
#define SBAR() __builtin_amdgcn_sched_barrier(0)
#define PIN(x) asm volatile("" : "+v"(x))
template <int ABL> __device__ __forceinline__ void ph_attn_unit(LAS unsigned char* lds, int bh, int qb, const bf16* U, const float* lamv, int layer, const float* dnw, const float* relb, bf16* Y, int wave_in) {
    int tid_ = wave_in * 64 + lane_id_now();
    const int tid = tid_, lane = tid & 63, wave = __builtin_amdgcn_readfirstlane(tid >> 6), map = wave >> 2, wq = wave & 3, c = lane & 31, h = lane >> 5;
    const int b = bh >> 2, hd = bh & 3, q0 = qb * 128, NT = 2 * (qb + 1), qi = q0 + 32 * wq + c;
    const size_t mb = (size_t)b * S;
    LAS float* btab = (LAS float*)(lds + AT_BT); LAS float* lam_s = (LAS float*)(lds + AT_LAM);
    __syncthreads();
    if (tid < 128) btab[tid] = (relb[t5_bucket(tid) * 4 + hd] - relb[31 * 4 + hd]) * L2E;
    if (tid == 128) { lam_s[0] = lamv[0]; lam_s[1] = lamv[1]; }
    bf16x8 qf[4];
    { const bf16* qp = U + (mb + qi) * NU + U_QD + hd * 128 + map * 64 + 8 * h;
#pragma unroll
      for (int d0 = 0; d0 < 4; ++d0) qf[d0] = *(const bf16x8*)(qp + 16 * d0); }
    const bf16* kg = U + mb * NU + U_KD + hd * 128; const bf16* vg = U + mb * NU + U_VD + hd * 128;
    const unsigned lds0 = (unsigned)(uintptr_t)lds;
    int goff[2];
#pragma unroll
    for (int i = 0; i < 2; ++i) { const int row = 8 * wave + 4 * i + (lane >> 4); goff[i] = row * NU + 8 * ((lane & 15) ^ swz16(row)); }
    int koff[4];
#pragma unroll
    for (int d0 = 0; d0 < 4; ++d0) koff[d0] = 256 * c + 16 * ((map * 8 + 2 * d0 + h) ^ swz16(c & 15));
    int voff[2][4];
    { const int g = lane >> 4, i16 = lane & 15, qq = i16 >> 2, pp = i16 & 3;
#pragma unroll
      for (int sec = 0; sec < 2; ++sec) { const int rl = 4 * h + qq + 8 * sec, sw = swz16(rl);
#pragma unroll
          for (int dblk = 0; dblk < 4; ++dblk) voff[sec][dblk] = AT_VO + 256 * rl + 16 * ((4 * dblk + 2 * (g & 1) + (pp >> 1)) ^ sw) + 8 * (pp & 1); } }
#define AT_DMA(tt, bufo) do { _Pragma("unroll") for (int i = 0; i < 2; ++i) { \
        at_glds16(kg + (size_t)(tt) * 64 * NU + goff[i], (unsigned)__builtin_amdgcn_readfirstlane(lds0 + (bufo) + 2048 * wave + 1024 * i)); \
        at_glds16(vg + (size_t)(tt) * 64 * NU + goff[i], (unsigned)__builtin_amdgcn_readfirstlane(lds0 + (bufo) + AT_VO + 2048 * wave + 1024 * i)); } } while (0)
    asm volatile("s_waitcnt vmcnt(0)" ::: "memory");
    AT_DMA(0, 0); AT_DMA(1, AT_BUF);
    AT_WAIT_BAR(4);
    f32x16 o[4];
#pragma unroll
    for (int d = 0; d < 4; ++d)
#pragma unroll
        for (int r = 0; r < 16; ++r) o[d][r] = 0.f;
    float mhat = 0.f, l = 0.f;
    f32x16 nm16 = {0.f, 0.f, 0.f, 0.f, 0.f, 0.f, 0.f, 0.f, 0.f, 0.f, 0.f, 0.f, 0.f, 0.f, 0.f, 0.f};
    const int qmax_w = q0 + 32 * wq + 31;
#define AT_E2(KB, R, PWD) do { const float e0 = __builtin_amdgcn_exp2f(p[KB][R]), e1 = __builtin_amdgcn_exp2f(p[KB][(R) + 1]); rs2 += (f32x2_t){e0, e1}; PWD = cvtpk(e0, e1); } while (0)
#define AT_GAP(CUR, DB, VC, PFC, VN, KSN, PWD) do { o[DB] = __builtin_amdgcn_mfma_f32_32x32x16_bf16(VC[DB], PFC, o[DB], 0, 0, 0); \
        VN[DB] = at_vfrag(lds + (CUR) + 256 * 16 * (KSN), voff[0][DB], voff[1][DB]); \
        AT_E2((KSN) >> 1, 8 * ((KSN) & 1) + 2 * (DB), PWD); PIN(PWD); PIN(rs2); SBAR(); } while (0)
#define AT_TILE_COMPUTE(t, cur) do { if ((t) * 64 <= qmax_w) { \
        bf16x8 kf[4]; bf16x8 va[4], vb[4]; f32x16 p[2]; \
        _Pragma("unroll") for (int dblk = 0; dblk < 4; ++dblk) va[dblk] = at_vfrag(lds + (cur), voff[0][dblk], voff[1][dblk]); \
        { bf16x8 kg2[4]; \
        _Pragma("unroll") for (int d0 = 0; d0 < 4; ++d0) { kf[d0] = *(const LAS bf16x8*)(lds + (cur) + koff[d0]); kg2[d0] = *(const LAS bf16x8*)(lds + (cur) + 8192 + koff[d0]); } \
        p[0] = __builtin_amdgcn_mfma_f32_32x32x16_bf16(kf[0], qf[0], nm16, 0, 0, 0); p[1] = __builtin_amdgcn_mfma_f32_32x32x16_bf16(kg2[0], qf[0], nm16, 0, 0, 0); \
        _Pragma("unroll") for (int d0 = 1; d0 < 4; ++d0) { p[0] = __builtin_amdgcn_mfma_f32_32x32x16_bf16(kf[d0], qf[d0], p[0], 0, 0, 0); p[1] = __builtin_amdgcn_mfma_f32_32x32x16_bf16(kg2[d0], qf[d0], p[1], 0, 0, 0); } } \
        if ((t) >= NT - 4) { int qrel = qi - (t) * 64 - 4 * h; asm volatile("" : "+v"(qrel));       \
            _Pragma("unroll") for (int kb = 0; kb < 2; ++kb) { float bbv[16];       \
                _Pragma("unroll") for (int r = 0; r < 16; ++r) { const int rel = qrel - (32 * kb + (r & 3) + 8 * (r >> 2)); bbv[r] = btab[rel < 0 ? 0 : (rel < 127 ? rel : 127)]; } \
                asm volatile("" : "+v"(bbv[0]), "+v"(bbv[1]), "+v"(bbv[2]), "+v"(bbv[3]), "+v"(bbv[4]), "+v"(bbv[5]), "+v"(bbv[6]), "+v"(bbv[7]), "+v"(bbv[8]), "+v"(bbv[9]), "+v"(bbv[10]), "+v"(bbv[11]), "+v"(bbv[12]), "+v"(bbv[13]), "+v"(bbv[14]), "+v"(bbv[15])); \
                _Pragma("unroll") for (int r = 0; r < 16; ++r) { const int rel = qrel - (32 * kb + (r & 3) + 8 * (r >> 2)); p[kb][r] = rel < 0 ? -INFINITY : p[kb][r] + bbv[r]; } } } \
        float ta = __builtin_fmaxf(__builtin_fmaxf(p[0][0], p[0][1]), p[1][0]), tb = __builtin_fmaxf(__builtin_fmaxf(p[0][2], p[0][3]), p[1][1]); ta = __builtin_fmaxf(__builtin_fmaxf(ta, p[1][2]), p[1][3]); \
        _Pragma("unroll") for (int r = 4; r < 16; r += 4) { ta = __builtin_fmaxf(__builtin_fmaxf(ta, p[0][r]), p[0][r + 1]); tb = __builtin_fmaxf(__builtin_fmaxf(tb, p[0][r + 2]), p[0][r + 3]); \
            ta = __builtin_fmaxf(__builtin_fmaxf(ta, p[1][r]), p[1][r + 1]); tb = __builtin_fmaxf(__builtin_fmaxf(tb, p[1][r + 2]), p[1][r + 3]); } \
        float tm = xhalf_max(__builtin_fmaxf(ta, tb)); \
        if ((t) == 0 || __any(tm > AT_THR)) {                        \
            const float dl = (t) == 0 ? tm : __builtin_fmaxf(tm, 0.f), f = (t) == 0 ? 1.0f : __builtin_amdgcn_exp2f(-dl); \
            mhat += dl; l *= f; _Pragma("unroll") for (int r = 0; r < 16; ++r) nm16[r] = -mhat; \
            _Pragma("unroll") for (int r = 0; r < 16; ++r) { p[0][r] -= dl; p[1][r] -= dl; } \
            _Pragma("unroll") for (int d = 0; d < 4; ++d) _Pragma("unroll") for (int r = 0; r < 16; ++r) o[d][r] *= f; } \
          \
        f32x2_t rs2 = {0.f, 0.f}; unsigned pa[4], pb[4]; \
        SBAR(); \
        AT_E2(0, 0, pa[0]); AT_E2(0, 2, pa[1]); AT_E2(0, 4, pa[2]); AT_E2(0, 6, pa[3]); PIN(pa[0]); PIN(pa[1]); PIN(pa[2]); PIN(pa[3]); PIN(rs2); SBAR(); \
        { const bf16x8 pf = __builtin_bit_cast(bf16x8, (v4u){pa[0], pa[1], pa[2], pa[3]}); \
          AT_GAP(cur, 0, va, pf, vb, 1, pb[0]); AT_GAP(cur, 1, va, pf, vb, 1, pb[1]); AT_GAP(cur, 2, va, pf, vb, 1, pb[2]); AT_GAP(cur, 3, va, pf, vb, 1, pb[3]); } \
        { const bf16x8 pf = __builtin_bit_cast(bf16x8, (v4u){pb[0], pb[1], pb[2], pb[3]}); \
          AT_GAP(cur, 0, vb, pf, va, 2, pa[0]); AT_GAP(cur, 1, vb, pf, va, 2, pa[1]); AT_GAP(cur, 2, vb, pf, va, 2, pa[2]); AT_GAP(cur, 3, vb, pf, va, 2, pa[3]); } \
        { const bf16x8 pf = __builtin_bit_cast(bf16x8, (v4u){pa[0], pa[1], pa[2], pa[3]}); \
          AT_GAP(cur, 0, va, pf, vb, 3, pb[0]); AT_GAP(cur, 1, va, pf, vb, 3, pb[1]); AT_GAP(cur, 2, va, pf, vb, 3, pb[2]); AT_GAP(cur, 3, va, pf, vb, 3, pb[3]); } \
        { const bf16x8 pf = __builtin_bit_cast(bf16x8, (v4u){pb[0], pb[1], pb[2], pb[3]}); \
          _Pragma("unroll") for (int dblk = 0; dblk < 4; ++dblk) o[dblk] = __builtin_amdgcn_mfma_f32_32x32x16_bf16(vb[dblk], pf, o[dblk], 0, 0, 0); } \
        l += rs2.x + rs2.y; \
    } } while (0)
    int bcur = 0, bnxt2 = 2 * AT_BUF;
    for (int t = 0; t < NT; ++t) {
        if (ABL != 4 && t + 2 < NT) AT_DMA(t + 2, bnxt2);
        AT_TILE_COMPUTE(t, bcur);
        if (t + 2 < NT) AT_WAIT_BAR(4); else AT_WAIT_BAR(0);
        bcur = (bcur == (AT_NBUF - 1) * AT_BUF) ? 0 : bcur + AT_BUF; bnxt2 = (bnxt2 == (AT_NBUF - 1) * AT_BUF) ? 0 : bnxt2 + AT_BUF;
    }
#undef AT_DMA
#undef AT_TILE_COMPUTE
#undef AT_GAP
#undef AT_E2
    const float lt = xhalf_sum(l);
    const float lam = lam_s[0], gsc = 1.0f - lam_s[1];
    LAS float* ex = (LAS float*)lds;
    if (map == 1) { const float inv = lam / lt;
#pragma unroll
        for (int d = 0; d < 4; ++d)
#pragma unroll
            for (int r = 0; r < 16; ++r) ex[(wq * 128 + 32 * d + crow(r, h)) * 32 + c] = o[d][r] * inv; }
    __syncthreads();
    if (map == 0) { const float inv = 1.0f / lt; float ss = 0.f;
#pragma unroll
        for (int d = 0; d < 4; ++d)
#pragma unroll
            for (int r = 0; r < 16; ++r) { const float v = o[d][r] * inv - ex[(wq * 128 + 32 * d + crow(r, h)) * 32 + c]; o[d][r] = v; ss += v * v; }
        ss = xhalf_sum(ss);
        const float rr = gsc * __builtin_amdgcn_rsqf(ss * (1.0f / 128.0f) + EPS);
        bf16* yp = Y + (mb + qi) * D + Y_D + hd * 128; const float* wp = dnw + hd * 128;
        f32x4 wv[4][4];
#pragma unroll
        for (int d = 0; d < 4; ++d)
#pragma unroll
            for (int r4 = 0; r4 < 4; ++r4) wv[d][r4] = *(const f32x4*)(wp + 32 * d + 8 * r4 + 4 * h);
#pragma unroll
        for (int d = 0; d < 4; ++d)
#pragma unroll
            for (int j = 0; j < 2; ++j) { unsigned x0, x1, y0, y1;
                { const f32x4 w = wv[d][2 * j]; x0 = cvtpk(o[d][8 * j] * rr * w.x, o[d][8 * j + 1] * rr * w.y); x1 = cvtpk(o[d][8 * j + 2] * rr * w.z, o[d][8 * j + 3] * rr * w.w); }
                { const f32x4 w = wv[d][2 * j + 1]; y0 = cvtpk(o[d][8 * j + 4] * rr * w.x, o[d][8 * j + 5] * rr * w.y); y1 = cvtpk(o[d][8 * j + 6] * rr * w.z, o[d][8 * j + 7] * rr * w.w); }
                const auto s0 = __builtin_amdgcn_permlane32_swap(x0, y0, false, false), s1 = __builtin_amdgcn_permlane32_swap(x1, y1, false, false);
                v4u ov; ov.x = s0[0]; ov.y = s1[0]; ov.z = s0[1]; ov.w = s1[1];
                *(v4u*)(yp + 32 * d + 16 * j + 8 * h) = ov; }
    }
}
__device__ __forceinline__ float log_sigmoid_f(float x) { return fminf(x, 0.f) - flog(1.0f + fexp(-fabsf(x))); }
__device__ __forceinline__ bf16x8 tr_frag(const LAS unsigned char* p) {
    const s16x4 lo = __builtin_bit_cast(s16x4, __builtin_amdgcn_ds_read_tr16_b64_v4i16((LAS s16x4*)p));
    const s16x4 hi = __builtin_bit_cast(s16x4, __builtin_amdgcn_ds_read_tr16_b64_v4i16((LAS s16x4*)(p + 1024)));
    return __builtin_shufflevector(lo, hi, 0, 1, 2, 3, 4, 5, 6, 7);
}
__device__ __forceinline__ int tr_lane_off(int lane) { const int g = lane >> 4, i16 = lane & 15; return 128 * (4 * (g >> 1) + (i16 >> 2)) + 32 * (g & 1) + 8 * (i16 & 3); }
__device__ __forceinline__ bf16x8 ones_frag(int lane) { const short v = (lane & 31) == 0 ? (short)0x3F80 : (short)0; return (bf16x8){v, v, v, v, v, v, v, v}; }
__device__ __forceinline__ void copy_v_tile(LAS unsigned char* Vt, const bf16* src  , int lane) {
    v4u r[8];
#pragma unroll
    for (int i = 0; i < 8; ++i) r[i] = *(const v4u*)(src + (size_t)(8 * i + (lane >> 3)) * NU + (lane & 7) * 8);
#pragma unroll
    for (int i = 0; i < 8; ++i) *(LAS v4u*)(Vt + (8 * i + (lane >> 3)) * 128 + (lane & 7) * 16) = r[i];
}
template <bool ONES> __device__ __forceinline__ void x1_state_mfma(const LAS unsigned char* Kt, const LAS unsigned char* Vt, int lane, bf16* Uout  ) {
    const int lo = tr_lane_off(lane), h = lane >> 5, cl = lane & 31;
    f32x16 acc[3][2];
#pragma unroll
    for (int a = 0; a < 3; ++a)
#pragma unroll
        for (int b2 = 0; b2 < 2; ++b2)
#pragma unroll
            for (int r = 0; r < 16; ++r) acc[a][b2][r] = 0.f;
    const bf16x8 onef = ones_frag(lane);
#pragma unroll
    for (int ks = 0; ks < 4; ++ks) {
        bf16x8 bfr[2];
#pragma unroll
        for (int kb = 0; kb < 2; ++kb) bfr[kb] = tr_frag(Kt + 2048 * ks + 64 * kb + lo);
#pragma unroll
        for (int vb = 0; vb < 2; ++vb) { const bf16x8 af = tr_frag(Vt + 2048 * ks + 64 * vb + lo);
#pragma unroll
            for (int kb = 0; kb < 2; ++kb) acc[vb][kb] = __builtin_amdgcn_mfma_f32_32x32x16_bf16(af, bfr[kb], acc[vb][kb], 0, 0, 0); }
        if (ONES) {
#pragma unroll
            for (int kb = 0; kb < 2; ++kb) acc[2][kb] = __builtin_amdgcn_mfma_f32_32x32x16_bf16(onef, bfr[kb], acc[2][kb], 0, 0, 0); }
    }
#pragma unroll
    for (int vb = 0; vb < 2; ++vb)
#pragma unroll
        for (int kb = 0; kb < 2; ++kb)
#pragma unroll
            for (int r = 0; r < 16; ++r) Uout[(32 * vb + crow(r, h)) * 64 + 32 * kb + cl] = (bf16)f2bf(acc[vb][kb][r]);
    if (ONES && h == 0) { Uout[64 * 64 + cl] = (bf16)f2bf(acc[2][0][0]); Uout[64 * 64 + 32 + cl] = (bf16)f2bf(acc[2][1][0]); }
}
__device__ __forceinline__ void x1_mlstm(LAS unsigned char* wl, int u, int lane_, const bf16* U, const float* gates, const float* cw, const float* cb, const float* igb, const float* fgb, bf16* QKM, bf16* UM, float* EM) {
    int lane = lane_; asm volatile("" : "+v"(lane));
    const int bh = u >> 6, c = u & 63, b = bh >> 2, hd = bh & 3; const size_t m0 = (size_t)b * S + c * 64;
    LAS unsigned short* At = (LAS unsigned short*)wl; LAS unsigned short* Rt = (LAS unsigned short*)(wl + 8192);
    const int cq = hd * 64 + lane, ck = 256 + hd * 64 + lane;
    const bf16* up = U + m0 * NU + U_QKM;
    copy_v_tile((LAS unsigned char*)At, up + 256 + hd * 64, lane);
    copy_v_tile((LAS unsigned char*)Rt, up + hd * 64, lane);
    float xq0 = 0.f, xq1 = 0.f, xq2 = 0.f, xk0 = 0.f, xk1 = 0.f, xk2 = 0.f;
    if (c > 0) { xq0 = bf2f(up[-3 * NU + cq]); xq1 = bf2f(up[-2 * NU + cq]); xq2 = bf2f(up[-1 * NU + cq]); xk0 = bf2f(up[-3 * NU + ck]); xk1 = bf2f(up[-2 * NU + ck]); xk2 = bf2f(up[-1 * NU + ck]); }
    const float gi = gates[(m0 + lane) * 8 + hd] + igb[hd], gf = gates[(m0 + lane) * 8 + 4 + hd] + fgb[hd];
    float wq[4], wk[4];
#pragma unroll
    for (int i = 0; i < 4; ++i) { wq[i] = cw[i * 512 + cq]; wk[i] = cw[i * 512 + ck]; }
    const float bq = cb[cq], bk = cb[ck];
    float bc = log_sigmoid_f(gf);
#pragma unroll
    for (int o = 1; o < 64; o <<= 1) { const float t = shl_from(bc, (lane - o) & 63); if (lane >= o) bc += t; }
    const float b31 = __int_as_float(__builtin_amdgcn_readlane(__float_as_int(bc), 31)), bL = __int_as_float(__builtin_amdgcn_readlane(__float_as_int(bc), 63));
    const float rq = fexp(bc - b31), rk = 0.125f * fexp(b31 - bc + gi);
    if (lane == 0) { EM[2 * u] = fexp(b31); EM[2 * u + 1] = fexp(bL - b31); }
    LDS_WAIT();
    bf16* qo = QKM + m0 * 512;
    f32x2_t X0 = {xq0, xk0}, X1 = {xq1, xk1}, X2 = {xq2, xk2};
    const f32x2_t W0 = {wq[0], wk[0]}, W1 = {wq[1], wk[1]}, W2 = {wq[2], wk[2]}, W3 = {wq[3], wk[3]}, Bq = {bq, bk};
#pragma unroll 8
    for (int s = 0; s < 64; ++s) {
        const f32x2_t X3 = {bf2f(Rt[s * 64 + lane]), bf2f(At[s * 64 + lane])};
        const f32x2_t A = Bq + ((W0 * X0 + W1 * X1) + (W2 * X2 + W3 * X3));
        const f32x2_t t = A * -1.4426950408889634f; f32x2_t e = {__builtin_amdgcn_exp2f(t.x), __builtin_amdgcn_exp2f(t.y)}; e = e + 1.0f;
        const f32x2_t r = {__builtin_amdgcn_rcpf(e.x), __builtin_amdgcn_rcpf(e.y)};
        const f32x2_t sc = {__int_as_float(__builtin_amdgcn_readlane(__float_as_int(rq), s)), __int_as_float(__builtin_amdgcn_readlane(__float_as_int(rk), s))};
        const f32x2_t o2 = (A * r) * sc;
        const unsigned pk = cvtpk(o2.x, o2.y); const unsigned short kb16 = (unsigned short)(pk >> 16);
        qo[cq] = (bf16)(pk & 0xffffu); qo[ck] = kb16; qo += 512;
        At[s * 64 + lane] = kb16;
        X0 = X1; X1 = X2; X2 = X3;
    }
    LDS_WAIT();
    copy_v_tile((LAS unsigned char*)Rt, U + m0 * NU + U_VM + hd * 64, lane);
    LDS_WAIT();
    x1_state_mfma<true>(wl, wl + 8192, lane, UM + (size_t)u * 65 * 64);
    LDS_WAIT();
}
__device__ __forceinline__ void x1_hgrn(LAS unsigned char* wl, int u, int lane_, const bf16* U, const float* lbl, int layer, bf16* QKH, bf16* UH, float* EH) {
    int lane = lane_; asm volatile("" : "+v"(lane));
    const int bh = u >> 6, c = u & 63, b = bh >> 2, hd = bh & 3; const size_t m0 = (size_t)b * S + c * 64;
    LAS unsigned short* At = (LAS unsigned short*)wl; LAS unsigned short* Rt = (LAS unsigned short*)(wl + 8192);
    copy_v_tile((LAS unsigned char*)At, U + m0 * NU + U_QH + hd * 64, lane);
    copy_v_tile((LAS unsigned char*)Rt, U + m0 * NU + U_FH + hd * 64, lane);
    const float lb = hgrn_lb(lbl, layer, hd * 64 + lane);
    LDS_WAIT();
    float B31 = 0.f, BL = 0.f; float fr[64];
#pragma unroll
    for (int s = 0; s < 64; ++s) { const float fp = bf2f(Rt[s * 64 + lane]); fr[s] = lb + (1.0f - lb) * fsigmoid(fp); BL += flog(fr[s]); if (s == 31) B31 = BL; }
    EH[(size_t)(2 * u) * 64 + lane] = fexp(B31); EH[(size_t)(2 * u + 1) * 64 + lane] = fexp(BL - B31);
    { float Bc = 0.f; bf16* qo = QKH + m0 * NU + hd * 64 + lane;
#pragma unroll
      for (int s = 0; s < 64; ++s) { const float f = fr[s]; Bc += flog(f);
        const float qraw = bf2f(At[s * 64 + lane]);
        const float qv = fsilu(qraw) * fexp(fminf(Bc - B31, 80.f)), kv = (1.0f - f) * fexp(fminf(B31 - Bc, 80.f));
        const unsigned pk = cvtpk(qv, kv); const unsigned short kb16 = (unsigned short)(pk >> 16);
        qo[U_QH] = (bf16)(pk & 0xffffu); qo[U_FH] = kb16; qo += NU;
        At[s * 64 + lane] = kb16; } }
    LDS_WAIT();
    copy_v_tile((LAS unsigned char*)Rt, U + m0 * NU + U_IH + hd * 64, lane);
    LDS_WAIT();
    x1_state_mfma<false>(wl, wl + 8192, lane, UH + (size_t)u * 64 * 64);
    LDS_WAIT();
}
__device__ __forceinline__ void x2_scan(int gt, int NT, const bf16* UM, const float* EM, bf16* CP, const bf16* UH, const float* EH, bf16* SP) {
    for (int p = gt; p < 2 * 65536; p += NT) {
        if (p < 65536) { const int e = 2 * p, bh = e >> 12, r = e & 4095; const bool nrow = r < 64; float s0 = 0.f, s1 = 0.f, n0 = 0.f, n1 = 0.f;
#pragma unroll
            for (int half = 0; half < 2; ++half) { unsigned uu[32], un[32]; float e1[32], e2[32];
#pragma unroll
                for (int c = 0; c < 32; ++c) { const int u = bh * 64 + half * 32 + c; uu[c] = __builtin_nontemporal_load((const unsigned*)&UM[(size_t)u * 4160 + r]);
                    un[c] = nrow ? __builtin_nontemporal_load((const unsigned*)&UM[(size_t)u * 4160 + 4096 + r]) : 0u; e1[c] = EM[2 * u]; e2[c] = EM[2 * u + 1]; }
#pragma unroll
                for (int c = 0; c < 32; ++c) { const int u = bh * 64 + half * 32 + c; const float d = e1[c] * e2[c];
                    *(unsigned*)&CP[(size_t)u * 4160 + r] = cvtpk(s0 * e1[c], s1 * e1[c]);
                    s0 = d * s0 + e2[c] * __uint_as_float(uu[c] << 16); s1 = d * s1 + e2[c] * __uint_as_float(uu[c] & 0xffff0000u);
                    if (nrow) { *(unsigned*)&CP[(size_t)u * 4160 + 4096 + r] = cvtpk(n0 * e1[c], n1 * e1[c]);
                        n0 = d * n0 + e2[c] * __uint_as_float(un[c] << 16); n1 = d * n1 + e2[c] * __uint_as_float(un[c] & 0xffff0000u); } } }
        } else { const int e = 2 * (p - 65536), bh = e >> 12, r = e & 4095, cc = r & 63; float s0 = 0.f, s1 = 0.f;
#pragma unroll
            for (int half = 0; half < 2; ++half) { unsigned uu[32]; f32x2_t e1[32], e2[32];
#pragma unroll
                for (int c = 0; c < 32; ++c) { const int u = bh * 64 + half * 32 + c; uu[c] = __builtin_nontemporal_load((const unsigned*)&UH[(size_t)u * 4096 + r]);
                    e1[c] = *(const f32x2_t*)&EH[(size_t)(2 * u) * 64 + cc]; e2[c] = *(const f32x2_t*)&EH[(size_t)(2 * u + 1) * 64 + cc]; }
#pragma unroll
                for (int c = 0; c < 32; ++c) { const int u = bh * 64 + half * 32 + c;
                    *(unsigned*)&SP[(size_t)u * 4096 + r] = cvtpk(s0 * e1[c].x, s1 * e1[c].y);
                    s0 = e1[c].x * e2[c].x * s0 + e2[c].x * __uint_as_float(uu[c] << 16); s1 = e1[c].y * e2[c].y * s1 + e2[c].y * __uint_as_float(uu[c] & 0xffff0000u); } }
        }
    }
}
template <int T> __device__ __forceinline__ void x3_unit(LAS unsigned char* wl, int u, int lane_, const bf16* U, const bf16* QK, const bf16* SPb, const float* nwt, bf16* Y) {
    constexpr int NVB = T == 0 ? 3 : 2, NROW = T == 0 ? 65 : 64;
    constexpr int QP = T == 0 ? 512 : NU, QO = T == 0 ? 0 : U_QH, KO = T == 0 ? 256 : U_FH;
    int lane = lane_; asm volatile("" : "+v"(lane));
    const int bh = u >> 6, c = u & 63, b = bh >> 2, hd = bh & 3, h = lane >> 5, cl = lane & 31; const size_t m0 = (size_t)b * S + c * 64;
    LAS unsigned char* Vt = wl;
    v4u vst[8];
    { const bf16* src = U + m0 * NU + (T == 0 ? U_VM : U_IH) + hd * 64;
#pragma unroll
      for (int i = 0; i < 8; ++i) vst[i] = *(const v4u*)(src + (size_t)(8 * i + (lane >> 3)) * NU + (lane & 7) * 8); }
    bf16x8 qf[2][4], kf[2][4], sf[NVB][4];
#pragma unroll
    for (int tb = 0; tb < 2; ++tb)
#pragma unroll
        for (int d0 = 0; d0 < 4; ++d0) { qf[tb][d0] = *(const bf16x8*)(QK + (m0 + 32 * tb + cl) * QP + QO + hd * 64 + 16 * d0 + 8 * h); kf[tb][d0] = *(const bf16x8*)(QK + (m0 + 32 * tb + cl) * QP + KO + hd * 64 + 16 * d0 + 8 * h); }
#pragma unroll
    for (int vb = 0; vb < NVB; ++vb) { const int row = (32 * vb + cl) < NROW ? (32 * vb + cl) : (NROW - 1);
#pragma unroll
        for (int d0 = 0; d0 < 4; ++d0) sf[vb][d0] = *(const bf16x8*)(SPb + ((size_t)u * NROW + row) * 64 + 16 * d0 + 8 * h); }
#pragma unroll
    for (int i = 0; i < 8; ++i) *(LAS v4u*)(Vt + (8 * i + (lane >> 3)) * 128 + (lane & 7) * 16) = vst[i];
    LDS_WAIT();
    const int lo = tr_lane_off(lane); const bf16x8 onef = ones_frag(lane);
    f32x4 nwv[2][4];
#pragma unroll
    for (int vb = 0; vb < 2; ++vb)
#pragma unroll
        for (int r4 = 0; r4 < 4; ++r4) nwv[vb][r4] = *(const f32x4*)(nwt + hd * 64 + 32 * vb + 8 * r4 + 4 * h);
#pragma unroll
    for (int tb = 0; tb < 2; ++tb) {
        const int t = 32 * tb + cl;
        const bf16* gp = U + (m0 + t) * NU + (T == 0 ? U_OM : U_GH) + hd * 64;
        v2u gu[2][4];
#pragma unroll
        for (int vb = 0; vb < 2; ++vb)
#pragma unroll
            for (int r4 = 0; r4 < 4; ++r4) gu[vb][r4] = *(const v2u*)(gp + 32 * vb + 8 * r4 + 4 * h);
        f32x16 acc[NVB];
#pragma unroll
        for (int vb = 0; vb < NVB; ++vb) {
#pragma unroll
            for (int r = 0; r < 16; ++r) acc[vb][r] = 0.f;
#pragma unroll
            for (int d0 = 0; d0 < 4; ++d0) acc[vb] = __builtin_amdgcn_mfma_f32_32x32x16_bf16(sf[vb][d0], qf[tb][d0], acc[vb], 0, 0, 0);
        }
#pragma unroll
        for (int sb = 0; sb <= tb; ++sb) {
            f32x16 st;
#pragma unroll
            for (int r = 0; r < 16; ++r) st[r] = 0.f;
#pragma unroll
            for (int d0 = 0; d0 < 4; ++d0) st = __builtin_amdgcn_mfma_f32_32x32x16_bf16(kf[sb][d0], qf[tb][d0], st, 0, 0, 0);
            if (sb == tb) {
#pragma unroll
                for (int r = 0; r < 16; ++r) if (crow(r, h) > cl) st[r] = 0.f;
            }
#pragma unroll
            for (int ks = 0; ks < 2; ++ks) {
                v4u pw; pw.x = cvtpk(st[8 * ks + 0], st[8 * ks + 1]); pw.y = cvtpk(st[8 * ks + 2], st[8 * ks + 3]); pw.z = cvtpk(st[8 * ks + 4], st[8 * ks + 5]); pw.w = cvtpk(st[8 * ks + 6], st[8 * ks + 7]);
                const bf16x8 pf = __builtin_bit_cast(bf16x8, pw);
#pragma unroll
                for (int vb = 0; vb < 2; ++vb) { const bf16x8 af = tr_frag(Vt + 128 * (32 * sb + 16 * ks) + 64 * vb + lo); acc[vb] = __builtin_amdgcn_mfma_f32_32x32x16_bf16(af, pf, acc[vb], 0, 0, 0); }
                if (T == 0) acc[NVB - 1] = __builtin_amdgcn_mfma_f32_32x32x16_bf16(onef, pf, acc[NVB - 1], 0, 0, 0);
            }
        }
        float sc = 1.0f;
        if (T == 0) { const float den = shl_from(acc[NVB - 1][0], cl); sc = 1.0f / fmaxf(fabsf(den), 1.0f); }
        float s1 = 0.f;
#pragma unroll
        for (int vb = 0; vb < 2; ++vb)
#pragma unroll
            for (int r = 0; r < 16; ++r) { acc[vb][r] *= sc; s1 += (T == 0) ? acc[vb][r] : acc[vb][r] * acc[vb][r]; }
        s1 += shx(s1, 32, lane);
        float mean = 0.f, rstd;
        if (T == 0) { mean = s1 * (1.0f / 64.0f); float s2 = 0.f;
#pragma unroll
            for (int vb = 0; vb < 2; ++vb)
#pragma unroll
                for (int r = 0; r < 16; ++r) { const float d = acc[vb][r] - mean; s2 += d * d; }
            s2 += shx(s2, 32, lane); rstd = __builtin_amdgcn_rsqf(s2 * (1.0f / 64.0f) + EPS); }
        else rstd = __builtin_amdgcn_rsqf(s1 * (1.0f / 64.0f) + EPS);
        bf16* yp = Y + (m0 + t) * D + (T == 0 ? Y_M : Y_H) + hd * 64;
#pragma unroll
        for (int vb = 0; vb < 2; ++vb)
#pragma unroll
            for (int r4 = 0; r4 < 4; ++r4) { const int dv = 32 * vb + 8 * r4 + 4 * h; const f32x4 w = nwv[vb][r4]; const v2u g2 = gu[vb][r4];
                float gv[4] = {bf2f(g2.x & 0xffffu), bf2f(g2.x >> 16), bf2f(g2.y & 0xffffu), bf2f(g2.y >> 16)}; float yv[4];
#pragma unroll
                for (int e = 0; e < 4; ++e) { const float gate = (T == 0) ? fsigmoid(gv[e]) : fsilu(gv[e]); yv[e] = (acc[vb][4 * r4 + e] - mean) * rstd * w[e] * gate; }
                v2u ov; ov.x = cvtpk(yv[0], yv[1]); ov.y = cvtpk(yv[2], yv[3]); *(v2u*)(yp + dv) = ov; }
    }
    LDS_WAIT();
}
#ifndef PROBE_UP
#define PROBE_UP 1
#endif
#ifndef PROBE_DOWN
#define PROBE_DOWN 1
#endif
#ifndef PROBE_INOUT
#define PROBE_INOUT 1
#endif
#ifndef PROBE_ATT
#define PROBE_ATT 1
#endif
#ifndef PROBE_X
#define PROBE_X 1
#endif
#ifndef PROBE_X1
#define PROBE_X1 PROBE_X
#endif
#ifndef PROBE_X2
#define PROBE_X2 PROBE_X
#endif
#ifndef PROBE_X3
#define PROBE_X3 PROBE_X
#endif
#ifndef PROBE_BAR
#define PROBE_BAR 1
#endif
#ifndef PROBE_THIN
#define PROBE_THIN 0
#endif
#ifndef PROBE_WCONV
#define PROBE_WCONV 1
#endif
#ifndef PROBE_ATT_ABL
#define PROBE_ATT_ABL 0
#endif
#ifndef MK_PER_PHASE
#define MK_PER_PHASE 0
#endif
constexpr int NWAVES = 8, NTHREADS = 512;
constexpr int RING_BYTES = 131072, LDSCTL_OFF = RING_BYTES, LDS_BYTES = 147456;
constexpr int CW_BAR = 4096;
constexpr size_t CTL_ZERO_BYTES = 64 * 1024;
constexpr int PH_PER_LAYER = 13, N_PHASES = 1 + DEPTH * PH_PER_LAYER;
struct Args { const float* in[18]; float* out; unsigned char* ws; int ph_lo, ph_hi; };
struct ArgsG { __attribute__((address_space(1))) const float* in[18]; __attribute__((address_space(1))) float* out; __attribute__((address_space(1))) unsigned char* ws; int ph_lo, ph_hi; };

__global__ void __launch_bounds__(NTHREADS, 2) mk_fwd(Args a) {
    extern __shared__ __attribute__((aligned(16))) unsigned char lds_raw[];
    LAS unsigned char* lds = (LAS unsigned char*)lds_raw;
    int tid = threadIdx.x, lane = tid & 63, wave = __builtin_amdgcn_readfirstlane(tid >> 6);
    const int G = gridDim.x, bx = blockIdx.x, NGW = G * NWAVES; int gw = bx * NWAVES + wave; const int wave_u = wave;
    typedef const __attribute__((address_space(4))) ArgsG* argp_t;
    argp_t ap = (argp_t)__builtin_amdgcn_kernarg_segment_ptr();
#define AS1(T, p) ((T*)(p))
#define P_ws AS1(unsigned char, ap->ws)
#define P_x AS1(const float, ap->in[0])
#define P_norm_w AS1(const float, ap->in[1])
#define P_w_in AS1(const float, ap->in[6])
#define P_w_out AS1(const float, ap->in[7])
#define P_conv_w AS1(const float, ap->in[8])
#define P_conv_b AS1(const float, ap->in[9])
#define P_igb AS1(const float, ap->in[10])
#define P_fgb AS1(const float, ap->in[11])
#define P_mnw AS1(const float, ap->in[12])
#define P_dlam AS1(const float, ap->in[13])
#define P_dnw AS1(const float, ap->in[14])
#define P_relb AS1(const float, ap->in[15])
#define P_lbl AS1(const float, ap->in[16])
#define P_hnw AS1(const float, ap->in[17])
#define P_out AS1(float, ap->out)
#define P_GW ((float*)(P_ws + WS_GW))
#define P_WI ((bf16*)(P_ws + WS_WI))
#define P_WO ((bf16*)(P_ws + WS_WO))
#define P_WIN ((bf16*)(P_ws + WS_WIN))
#define P_WOUT ((bf16*)(P_ws + WS_WOUT))
#define P_gates ((float*)(P_ws + WS_GATES))
#define P_RS ((float*)(P_ws + WS_RS))
#define P_XN ((bf16*)(P_ws + WS_XN))
#define P_U ((bf16*)(P_ws + WS_U))
#define P_HB P_U
#define P_HOUT ((bf16*)(P_ws + WS_HOUT))
#define P_Y ((bf16*)(P_ws + WS_Y))
#define P_QKM ((bf16*)(P_ws + WS_HOUT))
#define P_QKH P_U
#define P_UH ((bf16*)(P_ws + WS_HOUT + 32 * MiB))
#define P_SP ((bf16*)(P_ws + WS_WI))
#define P_UM ((bf16*)(P_ws + WS_MIX))
#define P_CP ((bf16*)(P_ws + WS_MIX + 33 * MiB))
#define P_EM ((float*)(P_ws + WS_MIX + 50 * MiB))
#define P_EH ((float*)(P_ws + WS_MIX + 51 * MiB))
    for (int u = tid; u < (LDS_BYTES - LDSCTL_OFF) / 4; u += NTHREADS) ((LAS unsigned*)(lds + LDSCTL_OFF))[u] = 0u;
    __syncthreads();
    XcdBarrier bar; bar.bar = (unsigned*)(P_ws + WS_CTL) + CW_BAR; bar.x = 0; bar.st = nullptr;
    if (!MK_PER_PHASE) bar = xcd_barrier_post((unsigned*)(P_ws + WS_CTL) + CW_BAR, (volatile LAS unsigned*)(lds + LDSCTL_OFF + 64), tid);
    const bool GRP = !MK_PER_PHASE && G == 256;
    if (GRP) grp_post((unsigned*)(P_ws + WS_CTL), bx, tid);
    const int lo = ap->ph_lo, hi = ap->ph_hi;
#define IN(k) (!MK_PER_PHASE || (lo <= (k) && (k) < hi))
#define GWV (GRP ? (((bx & 7) * (G >> 3) + (bx >> 3)) * NWAVES + wave_u) : gw)
#define SEAMG(k) do { if (!MK_PER_PHASE && IN(k) && IN((k) + 1)) { if (GRP) grp_barrier((unsigned*)(P_ws + WS_CTL), (unsigned*)(P_ws + WS_CTL) + CW_BAR, bx, G, (volatile LAS unsigned*)(lds + LDSCTL_OFF + 96), wave_u * 64 + lane_id_now()); \
        else xcd_barrier(bar, wave_u * 64 + lane_id_now()); } } while (0)
#define SEAM(k) do { if (!MK_PER_PHASE && IN(k) && IN((k) + 1)) for (int rb = 0; rb < PROBE_BAR; ++rb) xcd_barrier(bar, wave_u * 64 + lane_id_now()); } while (0)
    LAS float* wscr = (LAS float*)lds + wave * (64 * 33);
#define RELAUNDER() do { asm volatile("" : "+s"(ap)); int w_ = wave_u; asm volatile("" : "+s"(w_)); int l_ = lane_id_now(); wave = w_; lane = l_; tid = wave * 64 + lane; gw = bx * NWAVES + wave; wscr = (LAS float*)lds + wave * (64 * 33); } while (0)

    if (IN(0)) {
        thin_rows<0, false, false>(P_x, P_XN, nullptr, nullptr, 0.f, P_RS, nullptr, nullptr, nullptr, GWV, NGW, lane, GRP);
        for (int idx = bx * NTHREADS + tid; idx < DEPTH * 8 * D; idx += G * NTHREADS) { const int l = idx / (8 * D), r = idx % (8 * D), j = r / D, k = r % D;
            P_GW[idx] = P_norm_w[(size_t)(l * 6 + 2) * D + k] * P_w_in[(size_t)l * D * NIN + (size_t)k * NIN + 1024 + j]; }
        if (bx == 0 && tid < DEPTH) { float li; const float lam = diff_lambda(P_dlam + tid * 256, tid, li); P_GW[DEPTH * 8 * D + 2 * tid] = lam; P_GW[DEPTH * 8 * D + 2 * tid + 1] = li; }
        for (int rw = 0; rw < PROBE_WCONV; ++rw) wconv_items<1>(AS1(const float, ap->in[2]), D, 2 * FF, 2 * FF, P_norm_w, P_WI, wscr, gw, NGW, lane);
        for (int rw = 0; rw < PROBE_WCONV; ++rw) wconv_items<0>(AS1(const float, ap->in[3]), FF, D, D, nullptr, P_WO, wscr, gw, NGW, lane);
    }
    SEAM(0);
    for (int l = 0; l < DEPTH; ++l) {
        const int pb = 1 + l * PH_PER_LAYER;
        RELAUNDER();

        for (int half = 0; half < 2; ++half) {
            const int pf = pb + (half ? 10 : 0);
            if (IN(pf)) for (int rep = 0; rep < PROBE_UP; ++rep) { RELAUNDER(); pg8::Gemm g{P_XN, P_WI, M, 2 * FF, D}; pg8::StaticOrder So; So.init(M, 2 * FF, G, bx); pg8::EpiSwiGLU E{P_HB, FF, P_RS};
                pg8::gemm_phase<pg8::EpiSwiGLU, pg8::StaticOrder, false, true>(lds, g, So, E, tid); }
            SEAMG(pf);
            if (IN(pf + 1)) for (int rep = 0; rep < PROBE_DOWN; ++rep) { RELAUNDER(); pg8::Gemm g{P_HB, P_WO, M, D, FF}; pg8::StaticOrder So; So.init(M, D, G, bx); pg8::EpiBf16 E{P_HOUT, D, nullptr, 0, 0, 1.0f};
                pg8::gemm_phase<pg8::EpiBf16, pg8::StaticOrder, true, true>(lds, g, So, E, tid); }
            if (half == 0) SEAMG(pf + 1); else SEAM(pf + 1);
            if (half == 0) {
                if (IN(pb + 2)) { RELAUNDER();
                    LAS float* gwl = (LAS float*)(lds + 73728);
                    for (int i = tid; i < 8 * D / 4; i += NTHREADS) *(LAS f32x4*)(gwl + 4 * i) = *(const f32x4*)(P_GW + (size_t)l * 8 * D + 4 * i);
                    __syncthreads();
                    thin_rows<1, true, false>(nullptr, P_XN, P_HOUT, P_norm_w + (size_t)l * 6 * D + 1 * D, 0.5f, P_RS, nullptr, gwl, P_gates, GWV, NGW, lane, GRP);
                    for (int rw = 0; rw < PROBE_WCONV; ++rw) wconv_items<2>(P_w_in + (size_t)l * D * NIN, D, NIN, NU, P_norm_w + (size_t)l * 6 * D + 2 * D, P_WIN, wscr, gw, NGW, lane);
                    for (int rw = 0; rw < PROBE_WCONV; ++rw) wconv_items<0>(P_w_out + (size_t)l * D * D, D, D, D, nullptr, P_WOUT, wscr, gw, NGW, lane);
                }
                SEAM(pb + 2);
                if (IN(pb + 3)) for (int rep = 0; rep < PROBE_INOUT; ++rep) { RELAUNDER(); pg8::Gemm g{P_XN, P_WIN, M, NU, D}; pg8::StaticOrder So; So.init(M, NU, G, bx); pg8::EpiBf16RS E{P_U, NU, P_RS, U_QD / 256, U_KD / 256, 0.125f * 1.4426950408889634f};
                    pg8::gemm_phase<pg8::EpiBf16RS, pg8::StaticOrder, true, true>(lds, g, So, E, tid); }
                SEAMG(pb + 3);
                for (int mp = 0; mp < 2; ++mp) { const bool chunk_pass = GRP ? ((((bx ^ mp) & 1) == 0)) : (mp == 0);
                if (chunk_pass) {
                if (IN(pb + 4)) for (int rep = 0; rep < PROBE_X1; ++rep) { RELAUNDER();
                    LAS unsigned char* wl = lds + wave * 16384;
                    for (int u = GWV; u < 2048; u += NGW) x1_mlstm(wl, u, lane, P_U, P_gates, P_conv_w + (size_t)l * 4 * 512, P_conv_b + (size_t)l * 512, P_igb + l * 4, P_fgb + l * 4, P_QKM, P_UM, P_EM);
                    for (int u = GWV; u < 2048; u += NGW) x1_hgrn(wl, u, lane, P_U, P_lbl, l, P_QKH, P_UH, P_EH);
                }
                SEAMG(pb + 4);
                if (IN(pb + 5)) for (int rep = 0; rep < PROBE_X2; ++rep) { RELAUNDER(); x2_scan(GRP ? (((bx >> 3) < 16 ? 0 : 65536) + 8192 * (bx & 7) + ((bx >> 3) & 15) * NTHREADS + tid) : bx * NTHREADS + tid, G * NTHREADS, P_UM, P_EM, P_CP, P_UH, P_EH, P_SP); }
                SEAMG(pb + 5);
                if (IN(pb + 6)) for (int rep = 0; rep < PROBE_X3; ++rep) { RELAUNDER();
                    LAS unsigned char* wl = lds + wave * 16384;
                    for (int u = GWV; u < 2048; u += NGW) x3_unit<0>(wl, u, lane, P_U, P_QKM, P_CP, P_mnw + l * 256, P_Y);
                    for (int u = GWV; u < 2048; u += NGW) x3_unit<1>(wl, u, lane, P_U, P_QKH, P_SP, P_hnw + l * 256, P_Y);
                }
                } else {
                if (IN(pb + 7)) for (int rep = 0; rep < PROBE_ATT; ++rep) { RELAUNDER();
                    const int vcu = (G % 8 == 0) ? (bx & 7) * (G >> 3) + (bx >> 3) : bx;
                    for (int i = vcu; i < 1024; i += G) { int v = i & 255, k = i >> 8; const int s8 = v & 7;
                        int qb = k == 0 ? s8 : (k == 1 ? 15 - s8 : (k == 2 ? 16 + s8 : 31 - s8));
                        if (G == 256) { const int xw = bx >> 3, jj = xw & 15; v = 8 * (4 * (bx & 7) + (xw >> 4) + 2 * (k >> 1)); qb = (k & 1) ? 31 - jj : jj; }
                        ph_attn_unit<0>(lds, v >> 3, qb, P_U, P_GW + DEPTH * 8 * D + 2 * l, l, P_dnw + l * 512, P_relb, P_Y, wave_u);
#if PROBE_ATT_ABL
                        ph_attn_unit<PROBE_ATT_ABL>(lds, v >> 3, qb, P_U, P_GW + DEPTH * 8 * D + 2 * l, l, P_dnw + l * 512, P_relb, (bf16*)(P_ws + WS_HOUT), wave_u);
#endif
                    }
                }
                }
                __syncthreads();
                }
                SEAM(pb + 7);
                if (IN(pb + 8)) for (int rep = 0; rep < PROBE_INOUT; ++rep) { RELAUNDER(); pg8::Gemm g{P_Y, P_WOUT, M, D, D}; pg8::StaticOrder So; So.init(M, D, G, bx); pg8::EpiBf16 E{P_HOUT, D, nullptr, 0, 0, 1.0f};
                    pg8::gemm_phase<pg8::EpiBf16, pg8::StaticOrder, true, true>(lds, g, So, E, tid); }
                SEAMG(pb + 8);
                if (IN(pb + 9)) { RELAUNDER();
                    thin_rows<1, false, false>(nullptr, P_XN, P_HOUT, P_norm_w + (size_t)l * 6 * D + 3 * D, 1.0f, P_RS, nullptr, nullptr, nullptr, GWV, NGW, lane, GRP);
                    for (int rw = 0; rw < PROBE_WCONV; ++rw) wconv_items<1>(AS1(const float, ap->in[4]) + (size_t)l * D * 2 * FF, D, 2 * FF, 2 * FF, P_norm_w + (size_t)l * 6 * D + 4 * D, P_WI, wscr, gw, NGW, lane);
                    for (int rw = 0; rw < PROBE_WCONV; ++rw) wconv_items<0>(AS1(const float, ap->in[5]) + (size_t)l * FF * D, FF, D, D, nullptr, P_WO, wscr, gw, NGW, lane);
                }
                SEAM(pb + 9);
            } else {
                if (IN(pb + 12)) { RELAUNDER();
                    if (l + 1 < DEPTH) thin_rows<1, false, false>(nullptr, P_XN, P_HOUT, P_norm_w + (size_t)l * 6 * D + 5 * D, 0.5f, P_RS, nullptr, nullptr, nullptr, GWV, NGW, lane, GRP);
                    else thin_rows<1, false, true>(nullptr, P_XN, P_HOUT, P_norm_w + (size_t)l * 6 * D + 5 * D, 0.5f, nullptr, P_out, nullptr, nullptr, GWV, NGW, lane, GRP);
                    if (l + 1 < DEPTH) {
                        for (int rw = 0; rw < PROBE_WCONV; ++rw) wconv_items<1>(AS1(const float, ap->in[2]) + (size_t)(l + 1) * D * 2 * FF, D, 2 * FF, 2 * FF, P_norm_w + (size_t)l * 6 * D + 6 * D, P_WI, wscr, gw, NGW, lane);
                        for (int rw = 0; rw < PROBE_WCONV; ++rw) wconv_items<0>(AS1(const float, ap->in[3]) + (size_t)(l + 1) * FF * D, FF, D, D, nullptr, P_WO, wscr, gw, NGW, lane);
                    }
                }
                SEAM(pb + 12);
            }
        }
    }
#undef IN
#undef SEAM
#undef P_ws
#undef P_x
#undef P_norm_w
#undef P_w_in
#undef P_w_out
#undef P_conv_w
#undef P_conv_b
#undef P_igb
#undef P_fgb
#undef P_mnw
#undef P_dlam
#undef P_dnw
#undef P_relb
#undef P_lbl
#undef P_hnw
#undef P_out
#undef P_GW
#undef P_WI
#undef P_WO
#undef P_WIN
#undef P_WOUT
#undef P_gates
#undef P_RS
#undef P_XN
#undef P_U
#undef P_HB
#undef P_HOUT
#undef P_Y
#undef P_QKM
#undef P_QKH
#undef P_UH
#undef P_SP
#undef P_UM
#undef P_CP
#undef P_EM
#undef P_EH
}

extern "C" void kernel_launch(void* const* d_in, const int* in_sizes, int n_in, void* d_out, int out_size, void* d_ws, size_t ws_size, hipStream_t stream) {
    static int grid = 0;
    if (grid == 0) {
        if (n_in != 18 || in_sizes[0] != M * D || out_size != M * D || ws_size < WS_END) { fprintf(stderr, "kernel_launch: unexpected shapes n_in %d in0 %d out %d ws %zu\n", n_in, n_in > 0 ? in_sizes[0] : -1, out_size, ws_size); grid = -1; return; }
        int dev = 0, cus = 0, per_cu = 0;
        if (hipGetDevice(&dev) != hipSuccess || hipDeviceGetAttribute(&cus, hipDeviceAttributeMultiprocessorCount, dev) != hipSuccess) { grid = -1; return; }
        if (hipFuncSetAttribute((const void*)mk_fwd, hipFuncAttributeMaxDynamicSharedMemorySize, LDS_BYTES) != hipSuccess) { fprintf(stderr, "kernel_launch: hipFuncSetAttribute failed\n"); grid = -1; return; }
        if (hipOccupancyMaxActiveBlocksPerMultiprocessor(&per_cu, (const void*)mk_fwd, NTHREADS, LDS_BYTES) != hipSuccess || per_cu < 1) fprintf(stderr, "kernel_launch: occupancy query says %d\n", per_cu);
        (void)hipGetLastError();
        grid = cus;
    }
    if (grid < 0) return;
    if (hipMemsetAsync((char*)d_ws + WS_CTL, 0, CTL_ZERO_BYTES, stream) != hipSuccess) return;
    Args a{};
    for (int i = 0; i < 18; ++i) a.in[i] = (const float*)d_in[i];
    a.out = (float*)d_out; a.ws = (unsigned char*)d_ws;
#if MK_PER_PHASE
    for (int p = 0; p < N_PHASES; ++p) { a.ph_lo = p; a.ph_hi = p + 1; hipLaunchKernelGGL(mk_fwd, dim3(grid), dim3(NTHREADS), LDS_BYTES, stream, a); }
#else
    a.ph_lo = 0; a.ph_hi = N_PHASES;
    hipLaunchKernelGGL(mk_fwd, dim3(grid), dim3(NTHREADS), LDS_BYTES, stream, a);
#endif
}
```

```cpp
#include <hip/hip_runtime.h>
#include <cstdio>
#include <cstdint>

namespace pg8 {
#define PG8_LAS __attribute__((address_space(3)))
typedef unsigned short bf16_t;
typedef short bf16x8 __attribute__((ext_vector_type(8)));
typedef float f32x4 __attribute__((ext_vector_type(4)));
typedef unsigned u32x4 __attribute__((ext_vector_type(4)));
constexpr int BM = 256, BK = 64, HALF = 128, HTB = HALF * BK * 2  , STAGE_BYTES = 8 * HTB, NXCD = 8, WGM = 8;

__host__ __device__ __forceinline__ int lds_byte(int r, int c) { const int st = (r >> 4) * 2 + (c >> 5), rr = r & 15, cc = c & 31, ob = rr * 64 + cc * 2; return st * 1024 + (ob ^ (((ob >> 9) & 1) << 5)); }
__host__ __device__ __forceinline__ void stage_rc(int b, int& R, int& C) { const int st = b / 1024, sb = b % 1024, swz = sb ^ (((sb >> 9) & 1) << 5); R = (st >> 1) * 16 + swz / 64; C = (st & 1) * 32 + (swz % 64) / 2; }
__host__ __device__ __forceinline__ int perm32(int rho) { const int n = rho >> 4, i = rho & 15; return 8 * (i >> 2) + 4 * n + (i & 3); }

struct Unit { int pm, pn; };
struct Gemm { const bf16_t* A; const bf16_t* Bt; int M, N, K; };

struct StaticOrder {
    int nM, nN, nwg, G, c;
    __host__ __device__ void init(int M, int N, int G_, int c_) { nM = M / BM; nN = N / BM; nwg = nM * nN; G = G_; c = c_; }
    __host__ __device__ bool next(int i, Unit& u) const {
        const long L = (long)i * G + c; if (L >= nwg) return false;
        int wgid = (int)L; { const int q = nwg / NXCD, r = nwg % NXCD, xcd = wgid % NXCD, off = wgid / NXCD; wgid = (xcd < r ? xcd * (q + 1) : r * (q + 1) + (xcd - r) * q) + off; }
        const int nig = WGM * nN, gid = wgid / nig, fm = gid * WGM, gsz = (nM - fm) < WGM ? (nM - fm) : WGM;
        u.pm = fm + ((wgid % nig) % gsz); u.pn = (wgid % nig) / gsz; return true;
    }
    __device__ __forceinline__ void a_ready(const Unit&) const {}
    __device__ __forceinline__ void done(const Unit&) const {}
};

__device__ __forceinline__ unsigned cvt_pk_bf16(float lo, float hi) { unsigned r; asm volatile("v_cvt_pk_bf16_f32 %0, %1, %2" : "=v"(r) : "v"(lo), "v"(hi)); return r; }
typedef float f32x2 __attribute__((ext_vector_type(2)));
template <bool RS> struct EpiBf16T {
    static constexpr bool PERM = true, AFTER_DRAIN = false;
    bf16_t* O; int ldc; const float* rs; int ct_lo, ct_hi; float ct_scale;
    __device__ __forceinline__ void prefetch(float (&pre)[8], const Unit& u, int wr, int fr) const {
        if (RS) { const int row0 = u.pm * BM + wr * 64 + fr;
#pragma unroll
            for (int ai = 0; ai < 2; ++ai)
#pragma unroll
                for (int m = 0; m < 4; ++m) pre[ai * 4 + m] = rs[row0 + ai * HALF + m * 16]; } }
    __device__ __forceinline__ void operator()(const f32x4 (&acc)[2][2][4][2], const Unit& u, int wr, int wc, int fr, int fq, const float (&pre)[8]) const {
        const int row0 = u.pm * BM + wr * 64 + fr; const int col0 = u.pn * BM + wc * 32 + 8 * fq;
        float scv[2][4];
#pragma unroll
        for (int ai = 0; ai < 2; ++ai)
#pragma unroll
            for (int m = 0; m < 4; ++m) scv[ai][m] = (RS ? pre[ai * 4 + m] : 1.0f) * ((u.pn >= ct_lo && u.pn < ct_hi) ? ct_scale : 1.0f);
#pragma unroll
        for (int ai = 0; ai < 2; ++ai)
#pragma unroll
            for (int m = 0; m < 4; ++m) { bf16_t* rowp = O + (size_t)(row0 + ai * HALF + m * 16) * ldc + col0; const float sc = scv[ai][m];
#pragma unroll
                for (int bj = 0; bj < 2; ++bj) { const f32x4 v0 = acc[ai][bj][m][0] * sc, v1 = acc[ai][bj][m][1] * sc;
                    u32x4 w; w.x = cvt_pk_bf16(v0[0], v0[1]); w.y = cvt_pk_bf16(v0[2], v0[3]); w.z = cvt_pk_bf16(v1[0], v1[1]); w.w = cvt_pk_bf16(v1[2], v1[3]);
                    *(u32x4*)(rowp + bj * HALF) = w; } }
    }
};
typedef EpiBf16T<false> EpiBf16; typedef EpiBf16T<true> EpiBf16RS;
__device__ __forceinline__ float silu_f(float g) { return g * __builtin_amdgcn_rcpf(1.0f + __expf(-g)); }
typedef float f32x2e __attribute__((ext_vector_type(2))); typedef __bf16 bf16x2e __attribute__((ext_vector_type(2)));
struct EpiSwiGLU {
    static constexpr bool PERM = true, AFTER_DRAIN = false;
    bf16_t* O; int ldc; const float* rs;
    __device__ __forceinline__ void prefetch(float (&pre)[8], const Unit& u, int wr, int fr) const {
        const int row0 = u.pm * BM + wr * 64 + fr;
#pragma unroll
        for (int ai = 0; ai < 2; ++ai)
#pragma unroll
            for (int m = 0; m < 4; ++m) pre[ai * 4 + m] = rs[row0 + ai * HALF + m * 16]; }
    __device__ __forceinline__ void operator()(const f32x4 (&acc)[2][2][4][2], const Unit& u, int wr, int wc, int fr, int fq, const float (&pre)[8]) const {
        const int row0 = u.pm * BM + wr * 64 + fr; const int col0 = u.pn * HALF + wc * 32 + 8 * fq;
        float scv[2][4];
#pragma unroll
        for (int ai = 0; ai < 2; ++ai)
#pragma unroll
            for (int m = 0; m < 4; ++m) scv[ai][m] = pre[ai * 4 + m];
#pragma unroll
        for (int ai = 0; ai < 2; ++ai)
#pragma unroll
            for (int m = 0; m < 4; ++m) { bf16_t* rowp = O + (size_t)(row0 + ai * HALF + m * 16) * ldc + col0;
                const float sc = scv[ai][m], sl = -1.4426950408889634f * sc, s2 = sc * sc;
                unsigned wv_[4];
#pragma unroll
                for (int q = 0; q < 2; ++q)
#pragma unroll
                    for (int p = 0; p < 2; ++p) { const f32x4 gq = acc[ai][0][m][q], uq = acc[ai][1][m][q];
                        const f32x2e g = {gq[2 * p], gq[2 * p + 1]}, uu = {uq[2 * p], uq[2 * p + 1]};
                        const f32x2e t = g * sl; f32x2e ex = {__builtin_amdgcn_exp2f(t.x), __builtin_amdgcn_exp2f(t.y)}; ex = ex + 1.0f;
                        const f32x2e r = {__builtin_amdgcn_rcpf(ex.x), __builtin_amdgcn_rcpf(ex.y)};
                        const f32x2e o = ((g * uu) * s2) * r;
                        wv_[2 * q + p] = __builtin_bit_cast(unsigned, __builtin_convertvector(o, bf16x2e)); }
                u32x4 w; w.x = wv_[0]; w.y = wv_[1]; w.z = wv_[2]; w.w = wv_[3];
                *(u32x4*)rowp = w; }
    }
};
template <class Epi, class Sched, bool ALIGN_EPI = false, bool SP2 = false>
__device__ __forceinline__ void gemm_phase(PG8_LAS unsigned char* lds, const Gemm g, const Sched& S, const Epi& E, int tid_in) {
    int tid_ = tid_in; asm volatile("" : "+v"(tid_));
    const int tid = tid_, wid = __builtin_amdgcn_readfirstlane(tid >> 6), lane = tid & 63, wr = wid >> 2, wc = wid & 3, fr = lane & 15, fq = lane >> 4;
    const int K = g.K, nt = K / BK;
    unsigned voffA[2], voffB[2];
#pragma unroll
    for (int i = 0; i < 2; ++i) { int R, C; stage_rc(tid * 16 + i * 8192, R, C); const int Rb = Epi::PERM ? ((R & ~31) + perm32(R & 31)) : R;
        voffA[i] = (unsigned)(R * K + C) * 2u; voffB[i] = (unsigned)(Rb * K + C) * 2u; }
    const size_t kstep = (size_t)(BK * 2);
    const size_t hstep = (size_t)HALF * K * 2;
    const size_t tstep = 2 * hstep;
    const unsigned ldsw = (unsigned)wid * 1024u;
    const int aoff = lds_byte(wr * 64 + fr, fq * 8), boff = lds_byte(wc * 32 + fr, fq * 8);
#define PG8_SA(b, h) (((b) * 2 + (h)) * HTB)
#define PG8_SB(b, h) ((4 + (b) * 2 + (h)) * HTB)
#define PG8_STAGE(bufoff, gbase, voff) do { _Pragma("unroll") for (int _i = 0; _i < 2; ++_i) \
        __builtin_amdgcn_global_load_lds((const unsigned*)((const char*)(gbase) + (voff)[_i]), (PG8_LAS unsigned*)(lds + (bufoff) + ldsw + _i * 8192), 16, 0, 0); } while (0)
#define PG8_LDA(dst, b, h) do { _Pragma("unroll") for (int m = 0; m < 4; ++m) _Pragma("unroll") for (int k = 0; k < 2; ++k) dst[m][k] = *(const PG8_LAS bf16x8*)(lds + PG8_SA(b, h) + aoff + m * 2048 + k * 1024); } while (0)
#define PG8_LDB(dst, b, h) do { _Pragma("unroll") for (int n = 0; n < 2; ++n) _Pragma("unroll") for (int k = 0; k < 2; ++k) dst[n][k] = *(const PG8_LAS bf16x8*)(lds + PG8_SB(b, h) + boff + n * 2048 + k * 1024); } while (0)
#define PG8_MMA(ai, bj, At, Bt) do { __builtin_amdgcn_s_setprio(1); _Pragma("unroll") for (int m = 0; m < 4; ++m) _Pragma("unroll") for (int n = 0; n < 2; ++n) _Pragma("unroll") for (int k = 0; k < 2; ++k) \
        acc[ai][bj][m][n] = __builtin_amdgcn_mfma_f32_16x16x32_bf16(Bt[n][k], At[m][k], acc[ai][bj][m][n], 0, 0, 0); __builtin_amdgcn_s_setprio(0); } while (0)
#define PG8_WAIT_V(n) asm volatile("s_waitcnt vmcnt(" #n ")" ::: "memory")
#define PG8_WAIT_L(n) asm volatile("s_waitcnt lgkmcnt(" #n ")" ::: "memory")
#define PG8_BAR __builtin_amdgcn_s_barrier()
#define PG8_SCHED __builtin_amdgcn_sched_barrier(0)
    Unit cur, nxt; int ui = 0;
    float epre[8];
#pragma unroll
    for (int i = 0; i < 8; ++i) epre[i] = 1.0f;
    if (!S.next(0, cur)) return;
    f32x4 acc[2][2][4][2];
#pragma unroll
    for (int a = 0; a < 2; ++a)
#pragma unroll
        for (int b = 0; b < 2; ++b)
#pragma unroll
            for (int m = 0; m < 4; ++m)
#pragma unroll
                for (int n = 0; n < 2; ++n) acc[a][b][m][n] = (f32x4){0.f, 0.f, 0.f, 0.f};
    bf16x8 At[4][2], B0[2][2], B1[2][2];
    const char* cA = (const char*)g.A + (size_t)cur.pm * tstep; const char* cB = (const char*)g.Bt + (size_t)cur.pn * tstep;
    S.a_ready(cur);
    if constexpr (SP2) {
        PG8_STAGE(PG8_SB(0, 0), cB, voffB); PG8_STAGE(PG8_SB(0, 1), cB + hstep, voffB); PG8_STAGE(PG8_SA(0, 0), cA, voffA); PG8_STAGE(PG8_SA(0, 1), cA + hstep, voffA);
        if (wr == 1) PG8_BAR;
        PG8_WAIT_V(2); PG8_BAR;
        PG8_STAGE(PG8_SB(1, 0), cB + kstep, voffB); PG8_STAGE(PG8_SA(1, 0), cA + kstep, voffA); PG8_STAGE(PG8_SB(1, 1), cB + hstep + kstep, voffB);
        PG8_WAIT_V(6); PG8_BAR;
    } else {
        PG8_STAGE(PG8_SB(0, 0), cB, voffB); PG8_STAGE(PG8_SA(0, 0), cA, voffA); PG8_STAGE(PG8_SB(0, 1), cB + hstep, voffB); PG8_STAGE(PG8_SA(0, 1), cA + hstep, voffA);
        if (wr == 1) PG8_BAR;
        PG8_WAIT_V(4); PG8_BAR;
        PG8_STAGE(PG8_SB(1, 0), cB + kstep, voffB); PG8_STAGE(PG8_SA(1, 0), cA + kstep, voffA); PG8_STAGE(PG8_SB(1, 1), cB + hstep + kstep, voffB);
        PG8_WAIT_V(6); PG8_BAR;
    }
    for (;;) {
        const bool has_next = S.next(ui + 1, nxt);
        const char* nA = has_next ? (const char*)g.A + (size_t)nxt.pm * tstep : cA; const char* nB = has_next ? (const char*)g.Bt + (size_t)nxt.pn * tstep : cB;
        for (int t = 0; t < nt; t += 2) {
            const bool last = (t == nt - 2);
            const char* a1 = cA + (size_t)(t + 1) * kstep;
            const char* a2 = last ? nA : cA + (size_t)(t + 2) * kstep; const char* b2 = last ? nB : cB + (size_t)(t + 2) * kstep;
            const char* a3 = a2 + kstep; const char* b3 = b2 + kstep;
            if (last && has_next) S.a_ready(nxt);
            if (last) E.prefetch(epre, cur, wr, fr);
            if constexpr (SP2) {
            PG8_LDB(B0, 0, 0); PG8_LDB(B1, 0, 1); PG8_SCHED; PG8_LDA(At, 0, 0); PG8_STAGE(PG8_SA(1, 1), a1 + hstep, voffA);
            PG8_WAIT_V(8); PG8_WAIT_L(0); PG8_BAR; PG8_MMA(0, 0, At, B0); PG8_MMA(0, 1, At, B1); PG8_BAR; PG8_SCHED;
            PG8_LDA(At, 0, 1); PG8_STAGE(PG8_SB(0, 0), b2, voffB); PG8_STAGE(PG8_SB(0, 1), b2 + hstep, voffB); PG8_STAGE(PG8_SA(0, 0), a2, voffA);
            PG8_WAIT_V(8); PG8_WAIT_L(0); PG8_BAR; PG8_MMA(1, 0, At, B0); PG8_MMA(1, 1, At, B1); PG8_BAR; PG8_SCHED;
            PG8_LDB(B0, 1, 0); PG8_LDB(B1, 1, 1); PG8_SCHED; PG8_LDA(At, 1, 0); PG8_STAGE(PG8_SA(0, 1), a2 + hstep, voffA);
            PG8_WAIT_V(8); PG8_WAIT_L(0); PG8_BAR; PG8_MMA(0, 0, At, B0); PG8_MMA(0, 1, At, B1); PG8_BAR; PG8_SCHED;
            PG8_LDA(At, 1, 1); PG8_STAGE(PG8_SB(1, 0), b3, voffB); PG8_STAGE(PG8_SB(1, 1), b3 + hstep, voffB); PG8_STAGE(PG8_SA(1, 0), a3, voffA);
            PG8_WAIT_V(8); PG8_WAIT_L(0); PG8_BAR; PG8_MMA(1, 0, At, B0); PG8_MMA(1, 1, At, B1); PG8_BAR; PG8_SCHED;
            } else {
            PG8_LDB(B0, 0, 0); PG8_SCHED; PG8_LDA(At, 0, 0); PG8_STAGE(PG8_SA(1, 1), a1 + hstep, voffA);
            PG8_WAIT_L(8); PG8_BAR; PG8_WAIT_L(0); PG8_MMA(0, 0, At, B0); PG8_BAR; PG8_SCHED;
            PG8_LDB(B1, 0, 1); PG8_STAGE(PG8_SB(0, 0), b2, voffB);
            PG8_BAR; PG8_WAIT_L(0); PG8_MMA(0, 1, At, B1); PG8_BAR;
            PG8_LDA(At, 0, 1); PG8_STAGE(PG8_SA(0, 0), a2, voffA);
            PG8_BAR; PG8_WAIT_L(0); PG8_MMA(1, 0, At, B0); PG8_BAR; PG8_SCHED;
            PG8_STAGE(PG8_SB(0, 1), b2 + hstep, voffB);
            PG8_WAIT_V(6); PG8_BAR; PG8_MMA(1, 1, At, B1); PG8_BAR;
            PG8_LDB(B0, 1, 0); PG8_SCHED; PG8_LDA(At, 1, 0); PG8_STAGE(PG8_SA(0, 1), a2 + hstep, voffA);
            PG8_WAIT_L(8); PG8_BAR; PG8_WAIT_L(0); PG8_MMA(0, 0, At, B0); PG8_BAR; PG8_SCHED;
            PG8_LDB(B1, 1, 1); PG8_STAGE(PG8_SB(1, 0), b3, voffB);
            PG8_BAR; PG8_WAIT_L(0); PG8_MMA(0, 1, At, B1); PG8_BAR;
            PG8_LDA(At, 1, 1); PG8_STAGE(PG8_SA(1, 0), a3, voffA);
            PG8_BAR; PG8_WAIT_L(0); PG8_MMA(1, 0, At, B0); PG8_BAR; PG8_SCHED;
            PG8_STAGE(PG8_SB(1, 1), b3 + hstep, voffB);
            PG8_WAIT_V(6); PG8_BAR; PG8_MMA(1, 1, At, B1); PG8_BAR;
            }
        }
        if constexpr (ALIGN_EPI) { if (wr == 0) PG8_BAR; }
        if constexpr (!Epi::AFTER_DRAIN) { E(acc, cur, wr, wc, fr, fq, epre); S.done(cur); }
        if (!has_next) break;
#pragma unroll
        for (int a = 0; a < 2; ++a)
#pragma unroll
            for (int b = 0; b < 2; ++b)
#pragma unroll
                for (int m = 0; m < 4; ++m)
#pragma unroll
                    for (int n = 0; n < 2; ++n) acc[a][b][m][n] = (f32x4){0.f, 0.f, 0.f, 0.f};
        cur = nxt; cA = nA; cB = nB; ++ui;
        if constexpr (ALIGN_EPI) { if (wr == 1) PG8_BAR; }
    }
    PG8_WAIT_V(0);
    if constexpr (!ALIGN_EPI) { if (wr == 0) PG8_BAR; }
    PG8_BAR;
    if constexpr (Epi::AFTER_DRAIN) { E.fused(acc, cur, wr, wc, fr, fq, lds, wid, lane); S.done(cur); }
#undef PG8_SA
#undef PG8_SB
#undef PG8_STAGE
#undef PG8_LDA
#undef PG8_LDB
#undef PG8_MMA
#undef PG8_WAIT_V
#undef PG8_WAIT_L
#undef PG8_BAR
#undef PG8_SCHED
}
}
constexpr int NB = 8, S = 4096, D = 1024, M = NB * S, DEPTH = 4, FF = 2816, NU = 3584, NIN = 3592;
constexpr float EPS = 1e-6f;
constexpr int U_QKM = 0, U_VM = 512, U_OM = 768, U_QD = 1024, U_KD = 1536, U_VD = 2048, U_QH = 2560, U_FH = 2816, U_IH = 3072, U_GH = 3328;
constexpr int Y_M = 0, Y_D = 256, Y_H = 768;
typedef unsigned short bf16;
typedef float f32x4 __attribute__((ext_vector_type(4)));
typedef unsigned v4u __attribute__((ext_vector_type(4)));
typedef unsigned v2u __attribute__((ext_vector_type(2)));
#define LAS __attribute__((address_space(3)))
#define LDS_WAIT() asm volatile("s_waitcnt lgkmcnt(0)" ::: "memory")

constexpr size_t MiB = 1u << 20;
constexpr size_t WS_CTL = 0, WS_GW = 1 * MiB, WS_WI = 2 * MiB, WS_WO = 14 * MiB, WS_WIN = 20 * MiB, WS_WOUT = 28 * MiB, WS_GATES = 30 * MiB, WS_RS = 31 * MiB;
constexpr size_t WS_XN = 32 * MiB, WS_U = 96 * MiB, WS_HOUT = 320 * MiB, WS_Y = 384 * MiB, WS_MIX = 448 * MiB, WS_END = 504 * MiB;

__device__ __forceinline__ float bf2f(unsigned v) { return __uint_as_float(v << 16); }
__device__ __forceinline__ unsigned f2bf(float f) { unsigned u = __float_as_uint(f); return (u + 0x7fffu + ((u >> 16) & 1u)) >> 16; }
typedef float f32x2c_t __attribute__((ext_vector_type(2))); typedef __bf16 bf16x2c_t __attribute__((ext_vector_type(2)));
__device__ __forceinline__ unsigned pk2(float lo, float hi) { f32x2c_t v = {lo, hi}; bf16x2c_t b = __builtin_convertvector(v, bf16x2c_t); return __builtin_bit_cast(unsigned, b); }
__device__ __forceinline__ int lane_id_now() { int l; asm volatile("v_mbcnt_lo_u32_b32 %0, -1, 0\n\tv_mbcnt_hi_u32_b32 %0, -1, %0" : "=v"(l)); return l; }
__device__ __forceinline__ float shx(float v, int o, int lane) { return __int_as_float(__builtin_amdgcn_ds_bpermute((lane ^ o) << 2, __float_as_int(v))); }
__device__ __forceinline__ float shl_from(float v, int src_lane) { return __int_as_float(__builtin_amdgcn_ds_bpermute(src_lane << 2, __float_as_int(v))); }
template <int CTRL> __device__ __forceinline__ float dpp_add(float v) { return v + __builtin_bit_cast(float, __builtin_amdgcn_update_dpp(0, __builtin_bit_cast(int, v), CTRL, 0xf, 0xf, true)); }
__device__ __forceinline__ float wave_sum(float v, int lane) {
#pragma unroll
    for (int o = 1; o < 64; o <<= 1) v += shx(v, o, lane);
    return v;
}
__device__ __forceinline__ float sigmoid_f(float x) { return 1.0f / (1.0f + expf(-x)); }

template <int KIND> __device__ __forceinline__ int srccol(int n) {
    if (KIND == 1) { const int pn = n >> 8, j = n & 255; return j < 128 ? 128 * pn + j : FF + 128 * pn + (j - 128); }
    if (KIND == 2) return n < 1024 ? n : n + 8;
    return n;
}
template <int KIND> __device__ __forceinline__ void wconv_items(const float* W, int K, int Nsrc, int N, const float* nw, bf16* Bt, LAS float* scr, int gw, int NGW, int lane) {
    const int nblk = N / 32, nitems = (K / 64) * nblk;
    for (int it0 = gw; it0 < nitems; it0 += 2 * NGW) {
        const int it1 = it0 + NGW; const bool two = it1 < nitems;
        float wv[2][32]; int k0s[2], n0s[2];
#pragma unroll
        for (int q = 0; q < 2; ++q) { const int it = q == 0 ? it0 : (two ? it1 : it0); const int kb = it / nblk, nb = it % nblk, k0 = 64 * kb, n0 = 32 * nb, sc0 = srccol<KIND>(n0); k0s[q] = k0; n0s[q] = n0;
            if (q == 0 || two) {
#pragma unroll
                for (int i = 0; i < 32; ++i) { const int kk = 2 * i + (lane >> 5); wv[q][i] = __builtin_nontemporal_load(&W[(size_t)(k0 + kk) * Nsrc + sc0 + (lane & 31)]); }
            } else {
#pragma unroll
                for (int i = 0; i < 32; ++i) wv[q][i] = 0.f; } }
#pragma unroll
        for (int q = 0; q < 2; ++q) { if (q == 1 && !two) break; const int k0 = k0s[q], n0 = n0s[q];
            if (nw) { const float nwv = nw[k0 + lane];
#pragma unroll
                for (int i = 0; i < 32; ++i) { const float a = __int_as_float(__builtin_amdgcn_readlane(__float_as_int(nwv), 2 * i)), b2 = __int_as_float(__builtin_amdgcn_readlane(__float_as_int(nwv), 2 * i + 1)); wv[q][i] *= (lane < 32) ? a : b2; } }
#pragma unroll
            for (int i = 0; i < 32; ++i) scr[(2 * i + (lane >> 5)) * 33 + (lane & 31)] = wv[q][i];
            LDS_WAIT();
            const int c = lane & 7;
#pragma unroll
            for (int j = 0; j < 4; ++j) { const int n = (lane >> 3) + 8 * j; const LAS float* s = scr + (8 * c) * 33 + n;
                v4u o; o.x = pk2(s[0 * 33], s[1 * 33]); o.y = pk2(s[2 * 33], s[3 * 33]); o.z = pk2(s[4 * 33], s[5 * 33]); o.w = pk2(s[6 * 33], s[7 * 33]);
                *(v4u*)(Bt + (size_t)(n0 + n) * K + k0 + 8 * c) = o; }
            LDS_WAIT(); }
    }
}
template <int MODE, bool GATES, bool LAST> __device__ __forceinline__ void thin_rows(const float* xin, bf16* xb, const bf16* h, const float* wa, float c, float* rs, float* outf, const LAS float* gwl, float* gates, int gw, int NGW, int lane, bool contig  ) {
    constexpr int R = GATES ? 2 : 4;
    f32x4 wav[4];
    if (MODE == 1) {
#pragma unroll
        for (int j = 0; j < 4; ++j) wav[j] = *(const f32x4*)(wa + 4 * lane + 256 * j);
    }
    const int rpw = M / NGW;
    for (int mb = contig ? gw * rpw : gw * R, me = contig ? gw * rpw + rpw : M; mb < me; mb += contig ? R : NGW * R) {
        f32x4 xv[R][4]; v2u xr[R][4], hr[R][4];
#pragma unroll
        for (int i = 0; i < R; ++i) {
            if (MODE == 0) {
#pragma unroll
                for (int j = 0; j < 4; ++j) xv[i][j] = __builtin_nontemporal_load((const f32x4*)(xin + (size_t)(mb + i) * D + 4 * lane + 256 * j));
            } else {
#pragma unroll
                for (int j = 0; j < 4; ++j) { xr[i][j] = *(const v2u*)(xb + (size_t)(mb + i) * D + 4 * lane + 256 * j);
                    hr[i][j] = __builtin_nontemporal_load((const v2u*)(h + (size_t)(mb + i) * D + 4 * lane + 256 * j)); }
            } }
        float rx[R]; f32x4 hv[R][4];
        if (MODE == 1) { float ss[R];
#pragma unroll
            for (int i = 0; i < R; ++i) { ss[i] = 0.f;
#pragma unroll
                for (int j = 0; j < 4; ++j) { const v2u t = hr[i][j], q = xr[i][j];
                    hv[i][j].x = bf2f(t.x & 0xffffu); hv[i][j].y = bf2f(t.x >> 16); hv[i][j].z = bf2f(t.y & 0xffffu); hv[i][j].w = bf2f(t.y >> 16);
                    xv[i][j].x = bf2f(q.x & 0xffffu); xv[i][j].y = bf2f(q.x >> 16); xv[i][j].z = bf2f(q.y & 0xffffu); xv[i][j].w = bf2f(q.y >> 16);
                    ss[i] += (hv[i][j].x * hv[i][j].x + hv[i][j].y * hv[i][j].y) + (hv[i][j].z * hv[i][j].z + hv[i][j].w * hv[i][j].w); } }
#pragma unroll
            for (int i = 0; i < R; ++i) ss[i] = dpp_add<0xB1>(ss[i]);
#pragma unroll
            for (int i = 0; i < R; ++i) ss[i] = dpp_add<0x4E>(ss[i]);
#pragma unroll
            for (int i = 0; i < R; ++i) ss[i] = dpp_add<0x141>(ss[i]);
#pragma unroll
            for (int i = 0; i < R; ++i) ss[i] = dpp_add<0x140>(ss[i]);
#pragma unroll
            for (int o = 16; o < 64; o <<= 1) { float t[R];
#pragma unroll
                for (int i = 0; i < R; ++i) t[i] = shx(ss[i], o, lane);
#pragma unroll
                for (int i = 0; i < R; ++i) ss[i] += t[i]; }
#pragma unroll
            for (int i = 0; i < R; ++i) { const float rh = c * __builtin_amdgcn_rsqf(ss[i] * (1.0f / D) + EPS);
#pragma unroll
                for (int j = 0; j < 4; ++j) xv[i][j] = xv[i][j] + hv[i][j] * wav[j] * rh; }
        }
#pragma unroll
        for (int i = 0; i < R; ++i) rx[i] = 0.f;
        if (LAST) {
#pragma unroll
            for (int i = 0; i < R; ++i)
#pragma unroll
                for (int j = 0; j < 4; ++j) __builtin_nontemporal_store(xv[i][j], (f32x4*)(outf + (size_t)(mb + i) * D + 4 * lane + 256 * j));
        } else { float s2[R];
#pragma unroll
            for (int i = 0; i < R; ++i) { s2[i] = 0.f;
#pragma unroll
                for (int j = 0; j < 4; ++j) s2[i] += (xv[i][j].x * xv[i][j].x + xv[i][j].y * xv[i][j].y) + (xv[i][j].z * xv[i][j].z + xv[i][j].w * xv[i][j].w); }
#pragma unroll
            for (int i = 0; i < R; ++i) s2[i] = dpp_add<0xB1>(s2[i]);
#pragma unroll
            for (int i = 0; i < R; ++i) s2[i] = dpp_add<0x4E>(s2[i]);
#pragma unroll
            for (int i = 0; i < R; ++i) s2[i] = dpp_add<0x141>(s2[i]);
#pragma unroll
            for (int i = 0; i < R; ++i) s2[i] = dpp_add<0x140>(s2[i]);
#pragma unroll
            for (int o = 16; o < 64; o <<= 1) { float t[R];
#pragma unroll
                for (int i = 0; i < R; ++i) t[i] = shx(s2[i], o, lane);
#pragma unroll
                for (int i = 0; i < R; ++i) s2[i] += t[i]; }
            float rxl = 0.f;
#pragma unroll
            for (int i = 0; i < R; ++i) { rx[i] = __builtin_amdgcn_rsqf(s2[i] * (1.0f / D) + EPS); rxl = lane == i ? rx[i] : rxl; }
            if (lane < R) rs[mb + lane] = rxl;
#pragma unroll
            for (int i = 0; i < R; ++i)
#pragma unroll
                for (int j = 0; j < 4; ++j) { v2u o; o.x = pk2(xv[i][j].x, xv[i][j].y); o.y = pk2(xv[i][j].z, xv[i][j].w);
                    *(v2u*)(xb + (size_t)(mb + i) * D + 4 * lane + 256 * j) = o; }
        }
        if (GATES) {
            float v[16];
#pragma unroll
            for (int jg = 0; jg < 8; ++jg) { float p[R];
#pragma unroll
                for (int i = 0; i < R; ++i) p[i] = 0.f;
#pragma unroll
                for (int j = 0; j < 4; ++j) { const f32x4 t = *(const LAS f32x4*)(gwl + jg * D + 4 * lane + 256 * j);
#pragma unroll
                    for (int i = 0; i < R; ++i) p[i] += (xv[i][j].x * t.x + xv[i][j].y * t.y) + (xv[i][j].z * t.z + xv[i][j].w * t.w); }
#pragma unroll
                for (int i = 0; i < R; ++i) v[(i & 1) * 8 + jg] = p[i]; }
            const bool b5 = (lane >> 5) & 1, b4 = (lane >> 4) & 1, b3 = (lane >> 3) & 1, b2 = (lane >> 2) & 1;
            float w[8], x4[4], y2[2];
#pragma unroll
            for (int k = 0; k < 8; ++k) w[k] = (b5 ? v[8 + k] : v[k]) + shx(b5 ? v[k] : v[8 + k], 32, lane);
#pragma unroll
            for (int k = 0; k < 4; ++k) x4[k] = (b4 ? w[4 + k] : w[k]) + shx(b4 ? w[k] : w[4 + k], 16, lane);
#pragma unroll
            for (int k = 0; k < 2; ++k) y2[k] = (b3 ? x4[2 + k] : x4[k]) + shx(b3 ? x4[k] : x4[2 + k], 8, lane);
            float z = (b2 ? y2[1] : y2[0]) + shx(b2 ? y2[0] : y2[1], 4, lane);
            z += shx(z, 2, lane); z += shx(z, 1, lane);
            if ((lane & 3) == 0) gates[(size_t)(mb + (b5 ? 1 : 0)) * 8 + 4 * (b4 ? 1 : 0) + 2 * (b3 ? 1 : 0) + (b2 ? 1 : 0)] = z * (b5 ? rx[1 % R] : rx[0]);
        }
    }
}
#define XB_TMO      128
#define XB_XCNT(j)  (256  + 64 * (j))
#define XB_XSUB(j)  (1280 + 64 * (j))
#define XB_XGEN(j)  (2304 + 64 * (j))
#define XB_TOP      3328
#define XB_TOPGEN   3392
#define XCD_BAR_WORDS 3456
#define XB_SPIN_CAP (1u << 18)

__device__ __forceinline__ unsigned xb_ld(unsigned* p)              { return __hip_atomic_load(p, __ATOMIC_RELAXED, __HIP_MEMORY_SCOPE_AGENT); }
__device__ __forceinline__ unsigned xb_add(unsigned* p, unsigned v) { return __hip_atomic_fetch_add(p, v, __ATOMIC_RELAXED, __HIP_MEMORY_SCOPE_AGENT); }
__device__ __forceinline__ unsigned xb_xcc_id() { return (unsigned)__builtin_amdgcn_s_getreg((3 << 11) | 20) & 0xFu; }
#define XB_SPIN(cond, bar) do { unsigned _sp = 0; while (cond) { __builtin_amdgcn_s_sleep(1); \
    if ((++_sp & 255u) == 0u) { if (xb_ld(&(bar)[XB_TMO])) break; if (_sp > XB_SPIN_CAP) { atomicAdd(&(bar)[XB_TMO], 1u); break; } } } } while (0)

struct XcdBarrier {
    unsigned* bar; unsigned x;
    volatile LAS unsigned* st;
};

__device__ __forceinline__ XcdBarrier xcd_barrier_post(unsigned* bar, volatile LAS unsigned* st, int tid) {
    XcdBarrier b; b.bar = bar; b.x = xb_xcc_id(); b.st = st;
    if (tid == 0) (void)xb_add(&bar[XB_XCNT(b.x)], 1u);
    return b;
}
__device__ __forceinline__ void xcd_barrier_complete(unsigned* bar, unsigned x, unsigned& nloc, unsigned& nx) {
    const unsigned G = gridDim.x * gridDim.y * gridDim.z;
    unsigned sum, cnt, mine, sp = 0u;
    for (;;) {
        sum = 0u; cnt = 0u; mine = 0u;
#pragma unroll
        for (unsigned j = 0; j < 16; ++j) { const unsigned c = xb_ld(&bar[XB_XCNT(j)]); sum += c; cnt += (c > 0u) ? 1u : 0u; mine = (j == x) ? c : mine; }
        if (sum == G) break;
        __builtin_amdgcn_s_sleep(1);
        if ((++sp & 255u) == 0u) { if (xb_ld(&bar[XB_TMO])) break; if (sp > XB_SPIN_CAP) { atomicAdd(&bar[XB_TMO], 1u); break; } }
    }
    nloc = mine > 0u ? mine : 1u; nx = cnt > 0u ? cnt : 1u;
}

__device__ __forceinline__ void xcd_barrier(const XcdBarrier& b, int tid) {
    asm volatile("s_waitcnt vmcnt(0)" ::: "memory");
    __syncthreads();
    if (tid == 0) {
        unsigned* bar = b.bar;
        __builtin_amdgcn_s_waitcnt(0);
        unsigned nloc = b.st[0], nx = b.st[1];
        if (nloc == 0u) { xcd_barrier_complete(bar, b.x, nloc, nx); b.st[0] = nloc; b.st[1] = nx; }
        const unsigned old = xb_add(&bar[XB_XSUB(b.x)], 1u);
        const unsigned gen = old / nloc;
        if (old + 1u == (gen + 1u) * nloc) {
            __builtin_amdgcn_fence(__ATOMIC_RELEASE, "agent");
            asm volatile("s_waitcnt vmcnt(0)" ::: "memory");
            const unsigned og = xb_add(&bar[XB_TOP], 1u);
            const unsigned tg = og / nx;
            if (og + 1u == (tg + 1u) * nx) xb_add(&bar[XB_TOPGEN], 1u);
            else XB_SPIN(xb_ld(&bar[XB_TOPGEN]) == tg, bar);
            __builtin_amdgcn_fence(__ATOMIC_ACQUIRE, "agent");
            xb_add(&bar[XB_XGEN(b.x)], 1u);
            asm volatile("s_waitcnt vmcnt(0)" ::: "memory");
        } else {
            XB_SPIN(xb_ld(&bar[XB_XGEN(b.x)]) == gen, bar);
            __builtin_amdgcn_fence(__ATOMIC_ACQUIRE, "agent");
            asm volatile("s_waitcnt vmcnt(0)" ::: "memory");
        }
    }
    __syncthreads();
}

#define GB_X(g, x)  (8192 + 64 * (g) + (x))
#define GB_CNT(g)   (8192 + 512 + 64 * (g))
#define GB_GEN(g)   (8192 + 1024 + 64 * (g))
__device__ __forceinline__ void grp_post(unsigned* ctl, int bx, int tid) { if (tid == 0) (void)xb_add(&ctl[GB_X(bx & 7, xb_xcc_id())], 1u); }
__device__ __forceinline__ void grp_barrier(unsigned* ctl, unsigned* bar, int bx, int G, volatile LAS unsigned* st, int tid) {
    asm volatile("s_waitcnt vmcnt(0)" ::: "memory");
    __syncthreads();
    if (tid == 0) {
        const unsigned g = (unsigned)bx & 7u, ng = (unsigned)G >> 3;
        unsigned mode = st[0];
        if (mode == 0u) { const unsigned x = xb_xcc_id(); unsigned sum, mine, sp = 0u;
            for (;;) { sum = 0u; mine = 0u;
#pragma unroll
                for (unsigned j = 0; j < 16; ++j) { const unsigned c = xb_ld(&ctl[GB_X(g, j)]); sum += c; mine = (j == x) ? c : mine; }
                if (sum == ng) break;
                __builtin_amdgcn_s_sleep(1);
                if ((++sp & 255u) == 0u) { if (xb_ld(&bar[XB_TMO])) break; if (sp > XB_SPIN_CAP) { atomicAdd(&bar[XB_TMO], 1u); break; } } }
            mode = (sum == ng && mine == ng) ? 1u : 2u; st[0] = mode; }
        if (mode != 1u) { __builtin_amdgcn_fence(__ATOMIC_RELEASE, "agent"); asm volatile("s_waitcnt vmcnt(0)" ::: "memory"); }
        const unsigned old = xb_add(&ctl[GB_CNT(g)], 1u), gen = old / ng;
        if (old + 1u == (gen + 1u) * ng) xb_add(&ctl[GB_GEN(g)], 1u);
        else XB_SPIN(xb_ld(&ctl[GB_GEN(g)]) == gen, bar);
        __builtin_amdgcn_fence(__ATOMIC_ACQUIRE, "agent");
        asm volatile("s_waitcnt vmcnt(0)" ::: "memory");
    }
    __syncthreads();
}
__device__ __forceinline__ float silu_acc(float a) { return a / (1.0f + expf(-a)); }
__device__ __forceinline__ float fexp(float v) { return __builtin_amdgcn_exp2f(v * 1.4426950408889634f); }
__device__ __forceinline__ float flog(float v) { return __builtin_amdgcn_logf(v) * 0.6931471805599453f; }
__device__ __forceinline__ float fsigmoid(float v) { return __builtin_amdgcn_rcpf(1.0f + fexp(-v)); }
__device__ __forceinline__ float fsilu(float v) { return v * fsigmoid(v); }
__device__ __forceinline__ float hgrn_lb(const float* lbl, int layer, int c) {
    float l0 = lbl[c], l1 = lbl[256 + c], l2 = lbl[512 + c], l3 = lbl[768 + c];
    const float mx = fmaxf(fmaxf(l0, l1), fmaxf(l2, l3)); l0 = fexp(l0 - mx); l1 = fexp(l1 - mx); l2 = fexp(l2 - mx); l3 = fexp(l3 - mx);
    const float inv = __builtin_amdgcn_rcpf(l0 + l1 + l2 + l3); float lb = 0.f; if (layer >= 1) lb += l1 * inv; if (layer >= 2) lb += l2 * inv; if (layer >= 3) lb += l3 * inv;
    return fmaxf(lb, 0.f);
}
__device__ __forceinline__ int t5_bucket(int n) {
    if (n < 16) return n;
    const int v = 16 + (int)(logf((float)n / 16.0f) / logf(8.0f) * 16.0f); return v < 31 ? v : 31;
}
__device__ __forceinline__ float diff_lambda(const float* lamv, int layer, float& lam_init) {
    float a = 0.f, c = 0.f; for (int d = 0; d < 64; ++d) { a += lamv[d] * lamv[64 + d]; c += lamv[128 + d] * lamv[192 + d]; }
    lam_init = layer == 0 ? 0.2f : (layer == 1 ? 0.35550906759096934f : (layer == 2 ? 0.4707130183435842f : 0.5560582041556406f));
    return expf(a) - expf(c) + lam_init;
}
typedef short bf16x8 __attribute__((ext_vector_type(8)));
typedef short s16x4 __attribute__((ext_vector_type(4)));
typedef float f32x16 __attribute__((ext_vector_type(16)));
typedef float f32x2_t __attribute__((ext_vector_type(2))); typedef __bf16 bf16x2_t __attribute__((ext_vector_type(2)));
__device__ __forceinline__ unsigned cvtpk(float lo, float hi) { f32x2_t v = {lo, hi}; bf16x2_t b = __builtin_convertvector(v, bf16x2_t); return __builtin_bit_cast(unsigned, b); }
__device__ __forceinline__ float xhalf_max(float v) { unsigned a = __builtin_bit_cast(unsigned, v), b = a; asm volatile("s_nop 1\n\tv_permlane32_swap_b32 %0, %1" : "+v"(a), "+v"(b));
    return __builtin_fmaxf(__builtin_bit_cast(float, a), __builtin_bit_cast(float, b)); }
__device__ __forceinline__ float xhalf_sum(float v) { unsigned a = __builtin_bit_cast(unsigned, v), b = a; asm volatile("s_nop 1\n\tv_permlane32_swap_b32 %0, %1" : "+v"(a), "+v"(b));
    return __builtin_bit_cast(float, a) + __builtin_bit_cast(float, b); }
__device__ __forceinline__ int crow(int r, int h) { return (r & 3) + 8 * (r >> 2) + 4 * h; }
__device__ __forceinline__ int swz16(int row) { return ((row & 3) << 2) | ((row >> 2) & 3); }
__device__ __forceinline__ bf16x8 at_vfrag(const LAS unsigned char* base, int o0, int o1) {
    const s16x4 lo = __builtin_bit_cast(s16x4, __builtin_amdgcn_ds_read_tr16_b64_v4i16((LAS s16x4*)(base + o0)));
    const s16x4 hi = __builtin_bit_cast(s16x4, __builtin_amdgcn_ds_read_tr16_b64_v4i16((LAS s16x4*)(base + o1)));
    return __builtin_shufflevector(lo, hi, 0, 1, 2, 3, 4, 5, 6, 7);
}
constexpr int AT_BUF = 32768, AT_VO = 16384, AT_NBUF = 3, AT_BT = AT_NBUF * AT_BUF, AT_LAM = AT_BT + 512;
__device__ __forceinline__ void at_glds16(const void* gsrc, unsigned lds_dst) { unsigned keep;
    asm volatile("s_mov_b32 %0, m0\n\ts_mov_b32 m0, %2\n\ts_nop 0\n\tglobal_load_lds_dwordx4 %1, off\n\ts_mov_b32 m0, %0" : "=&s"(keep) : "v"(gsrc), "s"(lds_dst) : "memory"); }
#define AT_WAIT_BAR(N) asm volatile("s_waitcnt vmcnt(" #N ") lgkmcnt(0)\n\ts_barrier" ::: "memory")
constexpr float L2E = 1.4426950408889634f, C2 = 0.125f * 1.4426950408889634f, AT_THR = 8.0f;
#define SBAR() __builtin_amdgcn_sched_barrier(0)
#define PIN(x) asm volatile("" : "+v"(x))
template <int ABL> __device__ __forceinline__ void ph_attn_unit(LAS unsigned char* lds, int bh, int qb, const bf16* U, const float* lamv, int layer, const float* dnw, const float* relb, bf16* Y, int wave_in) {
    int tid_ = wave_in * 64 + lane_id_now();
    const int tid = tid_, lane = tid & 63, wave = __builtin_amdgcn_readfirstlane(tid >> 6), map = wave >> 2, wq = wave & 3, c = lane & 31, h = lane >> 5;
    const int b = bh >> 2, hd = bh & 3, q0 = qb * 128, NT = 2 * (qb + 1), qi = q0 + 32 * wq + c;
    const size_t mb = (size_t)b * S;
    LAS float* btab = (LAS float*)(lds + AT_BT); LAS float* lam_s = (LAS float*)(lds + AT_LAM);
    __syncthreads();
    if (tid < 128) btab[tid] = (relb[t5_bucket(tid) * 4 + hd] - relb[31 * 4 + hd]) * L2E;
    if (tid == 128) { lam_s[0] = lamv[0]; lam_s[1] = lamv[1]; }
    bf16x8 qf[4];
    { const bf16* qp = U + (mb + qi) * NU + U_QD + hd * 128 + map * 64 + 8 * h;
#pragma unroll
      for (int d0 = 0; d0 < 4; ++d0) qf[d0] = *(const bf16x8*)(qp + 16 * d0); }
    const bf16* kg = U + mb * NU + U_KD + hd * 128; const bf16* vg = U + mb * NU + U_VD + hd * 128;
    const unsigned lds0 = (unsigned)(uintptr_t)lds;
    int goff[2];
#pragma unroll
    for (int i = 0; i < 2; ++i) { const int row = 8 * wave + 4 * i + (lane >> 4); goff[i] = row * NU + 8 * ((lane & 15) ^ swz16(row)); }
    int koff[4];
#pragma unroll
    for (int d0 = 0; d0 < 4; ++d0) koff[d0] = 256 * c + 16 * ((map * 8 + 2 * d0 + h) ^ swz16(c & 15));
    int voff[2][4];
    { const int g = lane >> 4, i16 = lane & 15, qq = i16 >> 2, pp = i16 & 3;
#pragma unroll
      for (int sec = 0; sec < 2; ++sec) { const int rl = 4 * h + qq + 8 * sec, sw = swz16(rl);
#pragma unroll
          for (int dblk = 0; dblk < 4; ++dblk) voff[sec][dblk] = AT_VO + 256 * rl + 16 * ((4 * dblk + 2 * (g & 1) + (pp >> 1)) ^ sw) + 8 * (pp & 1); } }
#define AT_DMA(tt, bufo) do { _Pragma("unroll") for (int i = 0; i < 2; ++i) { \
        at_glds16(kg + (size_t)(tt) * 64 * NU + goff[i], (unsigned)__builtin_amdgcn_readfirstlane(lds0 + (bufo) + 2048 * wave + 1024 * i)); \
        at_glds16(vg + (size_t)(tt) * 64 * NU + goff[i], (unsigned)__builtin_amdgcn_readfirstlane(lds0 + (bufo) + AT_VO + 2048 * wave + 1024 * i)); } } while (0)
    asm volatile("s_waitcnt vmcnt(0)" ::: "memory");
    AT_DMA(0, 0); AT_DMA(1, AT_BUF);
    AT_WAIT_BAR(4);
    f32x16 o[4];
#pragma unroll
    for (int d = 0; d < 4; ++d)
#pragma unroll
        for (int r = 0; r < 16; ++r) o[d][r] = 0.f;
    float mhat = 0.f, l = 0.f;
    f32x16 nm16 = {0.f, 0.f, 0.f, 0.f, 0.f, 0.f, 0.f, 0.f, 0.f, 0.f, 0.f, 0.f, 0.f, 0.f, 0.f, 0.f};
    const int qmax_w = q0 + 32 * wq + 31;
#define AT_E2(KB, R, PWD) do { const float e0 = __builtin_amdgcn_exp2f(p[KB][R]), e1 = __builtin_amdgcn_exp2f(p[KB][(R) + 1]); rs2 += (f32x2_t){e0, e1}; PWD = cvtpk(e0, e1); } while (0)
#define AT_GAP(CUR, DB, VC, PFC, VN, KSN, PWD) do { o[DB] = __builtin_amdgcn_mfma_f32_32x32x16_bf16(VC[DB], PFC, o[DB], 0, 0, 0); \
        VN[DB] = at_vfrag(lds + (CUR) + 256 * 16 * (KSN), voff[0][DB], voff[1][DB]); \
        AT_E2((KSN) >> 1, 8 * ((KSN) & 1) + 2 * (DB), PWD); PIN(PWD); PIN(rs2); SBAR(); } while (0)
#define AT_TILE_COMPUTE(t, cur) do { if ((t) * 64 <= qmax_w) { \
        bf16x8 kf[4]; bf16x8 va[4], vb[4]; f32x16 p[2]; \
        _Pragma("unroll") for (int dblk = 0; dblk < 4; ++dblk) va[dblk] = at_vfrag(lds + (cur), voff[0][dblk], voff[1][dblk]); \
        { bf16x8 kg2[4]; \
        _Pragma("unroll") for (int d0 = 0; d0 < 4; ++d0) { kf[d0] = *(const LAS bf16x8*)(lds + (cur) + koff[d0]); kg2[d0] = *(const LAS bf16x8*)(lds + (cur) + 8192 + koff[d0]); } \
        p[0] = __builtin_amdgcn_mfma_f32_32x32x16_bf16(kf[0], qf[0], nm16, 0, 0, 0); p[1] = __builtin_amdgcn_mfma_f32_32x32x16_bf16(kg2[0], qf[0], nm16, 0, 0, 0); \
        _Pragma("unroll") for (int d0 = 1; d0 < 4; ++d0) { p[0] = __builtin_amdgcn_mfma_f32_32x32x16_bf16(kf[d0], qf[d0], p[0], 0, 0, 0); p[1] = __builtin_amdgcn_mfma_f32_32x32x16_bf16(kg2[d0], qf[d0], p[1], 0, 0, 0); } } \
        if ((t) >= NT - 4) { int qrel = qi - (t) * 64 - 4 * h; asm volatile("" : "+v"(qrel));       \
            _Pragma("unroll") for (int kb = 0; kb < 2; ++kb) { float bbv[16];       \
                _Pragma("unroll") for (int r = 0; r < 16; ++r) { const int rel = qrel - (32 * kb + (r & 3) + 8 * (r >> 2)); bbv[r] = btab[rel < 0 ? 0 : (rel < 127 ? rel : 127)]; } \
                asm volatile("" : "+v"(bbv[0]), "+v"(bbv[1]), "+v"(bbv[2]), "+v"(bbv[3]), "+v"(bbv[4]), "+v"(bbv[5]), "+v"(bbv[6]), "+v"(bbv[7]), "+v"(bbv[8]), "+v"(bbv[9]), "+v"(bbv[10]), "+v"(bbv[11]), "+v"(bbv[12]), "+v"(bbv[13]), "+v"(bbv[14]), "+v"(bbv[15])); \
                _Pragma("unroll") for (int r = 0; r < 16; ++r) { const int rel = qrel - (32 * kb + (r & 3) + 8 * (r >> 2)); p[kb][r] = rel < 0 ? -INFINITY : p[kb][r] + bbv[r]; } } } \
        float ta = __builtin_fmaxf(__builtin_fmaxf(p[0][0], p[0][1]), p[1][0]), tb = __builtin_fmaxf(__builtin_fmaxf(p[0][2], p[0][3]), p[1][1]); ta = __builtin_fmaxf(__builtin_fmaxf(ta, p[1][2]), p[1][3]); \
        _Pragma("unroll") for (int r = 4; r < 16; r += 4) { ta = __builtin_fmaxf(__builtin_fmaxf(ta, p[0][r]), p[0][r + 1]); tb = __builtin_fmaxf(__builtin_fmaxf(tb, p[0][r + 2]), p[0][r + 3]); \
            ta = __builtin_fmaxf(__builtin_fmaxf(ta, p[1][r]), p[1][r + 1]); tb = __builtin_fmaxf(__builtin_fmaxf(tb, p[1][r + 2]), p[1][r + 3]); } \
        float tm = xhalf_max(__builtin_fmaxf(ta, tb)); \
        if ((t) == 0 || __any(tm > AT_THR)) {                        \
            const float dl = (t) == 0 ? tm : __builtin_fmaxf(tm, 0.f), f = (t) == 0 ? 1.0f : __builtin_amdgcn_exp2f(-dl); \
            mhat += dl; l *= f; _Pragma("unroll") for (int r = 0; r < 16; ++r) nm16[r] = -mhat; \
            _Pragma("unroll") for (int r = 0; r < 16; ++r) { p[0][r] -= dl; p[1][r] -= dl; } \
            _Pragma("unroll") for (int d = 0; d < 4; ++d) _Pragma("unroll") for (int r = 0; r < 16; ++r) o[d][r] *= f; } \
          \
        f32x2_t rs2 = {0.f, 0.f}; unsigned pa[4], pb[4]; \
        SBAR(); \
        AT_E2(0, 0, pa[0]); AT_E2(0, 2, pa[1]); AT_E2(0, 4, pa[2]); AT_E2(0, 6, pa[3]); PIN(pa[0]); PIN(pa[1]); PIN(pa[2]); PIN(pa[3]); PIN(rs2); SBAR(); \
        { const bf16x8 pf = __builtin_bit_cast(bf16x8, (v4u){pa[0], pa[1], pa[2], pa[3]}); \
          AT_GAP(cur, 0, va, pf, vb, 1, pb[0]); AT_GAP(cur, 1, va, pf, vb, 1, pb[1]); AT_GAP(cur, 2, va, pf, vb, 1, pb[2]); AT_GAP(cur, 3, va, pf, vb, 1, pb[3]); } \
        { const bf16x8 pf = __builtin_bit_cast(bf16x8, (v4u){pb[0], pb[1], pb[2], pb[3]}); \
          AT_GAP(cur, 0, vb, pf, va, 2, pa[0]); AT_GAP(cur, 1, vb, pf, va, 2, pa[1]); AT_GAP(cur, 2, vb, pf, va, 2, pa[2]); AT_GAP(cur, 3, vb, pf, va, 2, pa[3]); } \
        { const bf16x8 pf = __builtin_bit_cast(bf16x8, (v4u){pa[0], pa[1], pa[2], pa[3]}); \
          AT_GAP(cur, 0, va, pf, vb, 3, pb[0]); AT_GAP(cur, 1, va, pf, vb, 3, pb[1]); AT_GAP(cur, 2, va, pf, vb, 3, pb[2]); AT_GAP(cur, 3, va, pf, vb, 3, pb[3]); } \
        { const bf16x8 pf = __builtin_bit_cast(bf16x8, (v4u){pb[0], pb[1], pb[2], pb[3]}); \
          _Pragma("unroll") for (int dblk = 0; dblk < 4; ++dblk) o[dblk] = __builtin_amdgcn_mfma_f32_32x32x16_bf16(vb[dblk], pf, o[dblk], 0, 0, 0); } \
        l += rs2.x + rs2.y; \
    } } while (0)
    int bcur = 0, bnxt2 = 2 * AT_BUF;
    for (int t = 0; t < NT; ++t) {
        if (ABL != 4 && t + 2 < NT) AT_DMA(t + 2, bnxt2);
        AT_TILE_COMPUTE(t, bcur);
        if (t + 2 < NT) AT_WAIT_BAR(4); else AT_WAIT_BAR(0);
        bcur = (bcur == (AT_NBUF - 1) * AT_BUF) ? 0 : bcur + AT_BUF; bnxt2 = (bnxt2 == (AT_NBUF - 1) * AT_BUF) ? 0 : bnxt2 + AT_BUF;
    }
#undef AT_DMA
#undef AT_TILE_COMPUTE
#undef AT_GAP
#undef AT_E2
    const float lt = xhalf_sum(l);
    const float lam = lam_s[0], gsc = 1.0f - lam_s[1];
    LAS float* ex = (LAS float*)lds;
    if (map == 1) { const float inv = lam / lt;
#pragma unroll
        for (int d = 0; d < 4; ++d)
#pragma unroll
            for (int r = 0; r < 16; ++r) ex[(wq * 128 + 32 * d + crow(r, h)) * 32 + c] = o[d][r] * inv; }
    __syncthreads();
    if (map == 0) { const float inv = 1.0f / lt; float ss = 0.f;
#pragma unroll
        for (int d = 0; d < 4; ++d)
#pragma unroll
            for (int r = 0; r < 16; ++r) { const float v = o[d][r] * inv - ex[(wq * 128 + 32 * d + crow(r, h)) * 32 + c]; o[d][r] = v; ss += v * v; }
        ss = xhalf_sum(ss);
        const float rr = gsc * __builtin_amdgcn_rsqf(ss * (1.0f / 128.0f) + EPS);
        bf16* yp = Y + (mb + qi) * D + Y_D + hd * 128; const float* wp = dnw + hd * 128;
        f32x4 wv[4][4];
#pragma unroll
        for (int d = 0; d < 4; ++d)
#pragma unroll
            for (int r4 = 0; r4 < 4; ++r4) wv[d][r4] = *(const f32x4*)(wp + 32 * d + 8 * r4 + 4 * h);
#pragma unroll
        for (int d = 0; d < 4; ++d)
#pragma unroll
            for (int j = 0; j < 2; ++j) { unsigned x0, x1, y0, y1;
                { const f32x4 w = wv[d][2 * j]; x0 = cvtpk(o[d][8 * j] * rr * w.x, o[d][8 * j + 1] * rr * w.y); x1 = cvtpk(o[d][8 * j + 2] * rr * w.z, o[d][8 * j + 3] * rr * w.w); }
                { const f32x4 w = wv[d][2 * j + 1]; y0 = cvtpk(o[d][8 * j + 4] * rr * w.x, o[d][8 * j + 5] * rr * w.y); y1 = cvtpk(o[d][8 * j + 6] * rr * w.z, o[d][8 * j + 7] * rr * w.w); }
                const auto s0 = __builtin_amdgcn_permlane32_swap(x0, y0, false, false), s1 = __builtin_amdgcn_permlane32_swap(x1, y1, false, false);
                v4u ov; ov.x = s0[0]; ov.y = s1[0]; ov.z = s0[1]; ov.w = s1[1];
                *(v4u*)(yp + 32 * d + 16 * j + 8 * h) = ov; }
    }
}
__device__ __forceinline__ float log_sigmoid_f(float x) { return fminf(x, 0.f) - flog(1.0f + fexp(-fabsf(x))); }
__device__ __forceinline__ bf16x8 tr_frag(const LAS unsigned char* p) {
    const s16x4 lo = __builtin_bit_cast(s16x4, __builtin_amdgcn_ds_read_tr16_b64_v4i16((LAS s16x4*)p));
    const s16x4 hi = __builtin_bit_cast(s16x4, __builtin_amdgcn_ds_read_tr16_b64_v4i16((LAS s16x4*)(p + 1024)));
    return __builtin_shufflevector(lo, hi, 0, 1, 2, 3, 4, 5, 6, 7);
}
__device__ __forceinline__ int tr_lane_off(int lane) { const int g = lane >> 4, i16 = lane & 15; return 128 * (4 * (g >> 1) + (i16 >> 2)) + 32 * (g & 1) + 8 * (i16 & 3); }
__device__ __forceinline__ bf16x8 ones_frag(int lane) { const short v = (lane & 31) == 0 ? (short)0x3F80 : (short)0; return (bf16x8){v, v, v, v, v, v, v, v}; }
__device__ __forceinline__ void copy_v_tile(LAS unsigned char* Vt, const bf16* src  , int lane) {
    v4u r[8];
#pragma unroll
    for (int i = 0; i < 8; ++i) r[i] = *(const v4u*)(src + (size_t)(8 * i + (lane >> 3)) * NU + (lane & 7) * 8);
#pragma unroll
    for (int i = 0; i < 8; ++i) *(LAS v4u*)(Vt + (8 * i + (lane >> 3)) * 128 + (lane & 7) * 16) = r[i];
}
template <bool ONES> __device__ __forceinline__ void x1_state_mfma(const LAS unsigned char* Kt, const LAS unsigned char* Vt, int lane, bf16* Uout  ) {
    const int lo = tr_lane_off(lane), h = lane >> 5, cl = lane & 31;
    f32x16 acc[3][2];
#pragma unroll
    for (int a = 0; a < 3; ++a)
#pragma unroll
        for (int b2 = 0; b2 < 2; ++b2)
#pragma unroll
            for (int r = 0; r < 16; ++r) acc[a][b2][r] = 0.f;
    const bf16x8 onef = ones_frag(lane);
#pragma unroll
    for (int ks = 0; ks < 4; ++ks) {
        bf16x8 bfr[2];
#pragma unroll
        for (int kb = 0; kb < 2; ++kb) bfr[kb] = tr_frag(Kt + 2048 * ks + 64 * kb + lo);
#pragma unroll
        for (int vb = 0; vb < 2; ++vb) { const bf16x8 af = tr_frag(Vt + 2048 * ks + 64 * vb + lo);
#pragma unroll
            for (int kb = 0; kb < 2; ++kb) acc[vb][kb] = __builtin_amdgcn_mfma_f32_32x32x16_bf16(af, bfr[kb], acc[vb][kb], 0, 0, 0); }
        if (ONES) {
#pragma unroll
            for (int kb = 0; kb < 2; ++kb) acc[2][kb] = __builtin_amdgcn_mfma_f32_32x32x16_bf16(onef, bfr[kb], acc[2][kb], 0, 0, 0); }
    }
#pragma unroll
    for (int vb = 0; vb < 2; ++vb)
#pragma unroll
        for (int kb = 0; kb < 2; ++kb)
#pragma unroll
            for (int r = 0; r < 16; ++r) Uout[(32 * vb + crow(r, h)) * 64 + 32 * kb + cl] = (bf16)f2bf(acc[vb][kb][r]);
    if (ONES && h == 0) { Uout[64 * 64 + cl] = (bf16)f2bf(acc[2][0][0]); Uout[64 * 64 + 32 + cl] = (bf16)f2bf(acc[2][1][0]); }
}
__device__ __forceinline__ void x1_mlstm(LAS unsigned char* wl, int u, int lane_, const bf16* U, const float* gates, const float* cw, const float* cb, const float* igb, const float* fgb, bf16* QKM, bf16* UM, float* EM) {
    int lane = lane_; asm volatile("" : "+v"(lane));
    const int bh = u >> 6, c = u & 63, b = bh >> 2, hd = bh & 3; const size_t m0 = (size_t)b * S + c * 64;
    LAS unsigned short* At = (LAS unsigned short*)wl; LAS unsigned short* Rt = (LAS unsigned short*)(wl + 8192);
    const int cq = hd * 64 + lane, ck = 256 + hd * 64 + lane;
    const bf16* up = U + m0 * NU + U_QKM;
    copy_v_tile((LAS unsigned char*)At, up + 256 + hd * 64, lane);
    copy_v_tile((LAS unsigned char*)Rt, up + hd * 64, lane);
    float xq0 = 0.f, xq1 = 0.f, xq2 = 0.f, xk0 = 0.f, xk1 = 0.f, xk2 = 0.f;
    if (c > 0) { xq0 = bf2f(up[-3 * NU + cq]); xq1 = bf2f(up[-2 * NU + cq]); xq2 = bf2f(up[-1 * NU + cq]); xk0 = bf2f(up[-3 * NU + ck]); xk1 = bf2f(up[-2 * NU + ck]); xk2 = bf2f(up[-1 * NU + ck]); }
    const float gi = gates[(m0 + lane) * 8 + hd] + igb[hd], gf = gates[(m0 + lane) * 8 + 4 + hd] + fgb[hd];
    float wq[4], wk[4];
#pragma unroll
    for (int i = 0; i < 4; ++i) { wq[i] = cw[i * 512 + cq]; wk[i] = cw[i * 512 + ck]; }
    const float bq = cb[cq], bk = cb[ck];
    float bc = log_sigmoid_f(gf);
#pragma unroll
    for (int o = 1; o < 64; o <<= 1) { const float t = shl_from(bc, (lane - o) & 63); if (lane >= o) bc += t; }
    const float b31 = __int_as_float(__builtin_amdgcn_readlane(__float_as_int(bc), 31)), bL = __int_as_float(__builtin_amdgcn_readlane(__float_as_int(bc), 63));
    const float rq = fexp(bc - b31), rk = 0.125f * fexp(b31 - bc + gi);
    if (lane == 0) { EM[2 * u] = fexp(b31); EM[2 * u + 1] = fexp(bL - b31); }
    LDS_WAIT();
    bf16* qo = QKM + m0 * 512;
    f32x2_t X0 = {xq0, xk0}, X1 = {xq1, xk1}, X2 = {xq2, xk2};
    const f32x2_t W0 = {wq[0], wk[0]}, W1 = {wq[1], wk[1]}, W2 = {wq[2], wk[2]}, W3 = {wq[3], wk[3]}, Bq = {bq, bk};
#pragma unroll 8
    for (int s = 0; s < 64; ++s) {
        const f32x2_t X3 = {bf2f(Rt[s * 64 + lane]), bf2f(At[s * 64 + lane])};
        const f32x2_t A = Bq + ((W0 * X0 + W1 * X1) + (W2 * X2 + W3 * X3));
        const f32x2_t t = A * -1.4426950408889634f; f32x2_t e = {__builtin_amdgcn_exp2f(t.x), __builtin_amdgcn_exp2f(t.y)}; e = e + 1.0f;
        const f32x2_t r = {__builtin_amdgcn_rcpf(e.x), __builtin_amdgcn_rcpf(e.y)};
        const f32x2_t sc = {__int_as_float(__builtin_amdgcn_readlane(__float_as_int(rq), s)), __int_as_float(__builtin_amdgcn_readlane(__float_as_int(rk), s))};
        const f32x2_t o2 = (A * r) * sc;
        const unsigned pk = cvtpk(o2.x, o2.y); const unsigned short kb16 = (unsigned short)(pk >> 16);
        qo[cq] = (bf16)(pk & 0xffffu); qo[ck] = kb16; qo += 512;
        At[s * 64 + lane] = kb16;
        X0 = X1; X1 = X2; X2 = X3;
    }
    LDS_WAIT();
    copy_v_tile((LAS unsigned char*)Rt, U + m0 * NU + U_VM + hd * 64, lane);
    LDS_WAIT();
    x1_state_mfma<true>(wl, wl + 8192, lane, UM + (size_t)u * 65 * 64);
    LDS_WAIT();
}
__device__ __forceinline__ void x1_hgrn(LAS unsigned char* wl, int u, int lane_, const bf16* U, const float* lbl, int layer, bf16* QKH, bf16* UH, float* EH) {
    int lane = lane_; asm volatile("" : "+v"(lane));
    const int bh = u >> 6, c = u & 63, b = bh >> 2, hd = bh & 3; const size_t m0 = (size_t)b * S + c * 64;
    LAS unsigned short* At = (LAS unsigned short*)wl; LAS unsigned short* Rt = (LAS unsigned short*)(wl + 8192);
    copy_v_tile((LAS unsigned char*)At, U + m0 * NU + U_QH + hd * 64, lane);
    copy_v_tile((LAS unsigned char*)Rt, U + m0 * NU + U_FH + hd * 64, lane);
    const float lb = hgrn_lb(lbl, layer, hd * 64 + lane);
    LDS_WAIT();
    float B31 = 0.f, BL = 0.f; float fr[64];
#pragma unroll
    for (int s = 0; s < 64; ++s) { const float fp = bf2f(Rt[s * 64 + lane]); fr[s] = lb + (1.0f - lb) * fsigmoid(fp); BL += flog(fr[s]); if (s == 31) B31 = BL; }
    EH[(size_t)(2 * u) * 64 + lane] = fexp(B31); EH[(size_t)(2 * u + 1) * 64 + lane] = fexp(BL - B31);
    { float Bc = 0.f; bf16* qo = QKH + m0 * NU + hd * 64 + lane;
#pragma unroll
      for (int s = 0; s < 64; ++s) { const float f = fr[s]; Bc += flog(f);
        const float qraw = bf2f(At[s * 64 + lane]);
        const float qv = fsilu(qraw) * fexp(fminf(Bc - B31, 80.f)), kv = (1.0f - f) * fexp(fminf(B31 - Bc, 80.f));
        const unsigned pk = cvtpk(qv, kv); const unsigned short kb16 = (unsigned short)(pk >> 16);
        qo[U_QH] = (bf16)(pk & 0xffffu); qo[U_FH] = kb16; qo += NU;
        At[s * 64 + lane] = kb16; } }
    LDS_WAIT();
    copy_v_tile((LAS unsigned char*)Rt, U + m0 * NU + U_IH + hd * 64, lane);
    LDS_WAIT();
    x1_state_mfma<false>(wl, wl + 8192, lane, UH + (size_t)u * 64 * 64);
    LDS_WAIT();
}
__device__ __forceinline__ void x2_scan(int gt, int NT, const bf16* UM, const float* EM, bf16* CP, const bf16* UH, const float* EH, bf16* SP) {
    for (int p = gt; p < 2 * 65536; p += NT) {
        if (p < 65536) { const int e = 2 * p, bh = e >> 12, r = e & 4095; const bool nrow = r < 64; float s0 = 0.f, s1 = 0.f, n0 = 0.f, n1 = 0.f;
#pragma unroll
            for (int half = 0; half < 2; ++half) { unsigned uu[32], un[32]; float e1[32], e2[32];
#pragma unroll
                for (int c = 0; c < 32; ++c) { const int u = bh * 64 + half * 32 + c; uu[c] = __builtin_nontemporal_load((const unsigned*)&UM[(size_t)u * 4160 + r]);
                    un[c] = nrow ? __builtin_nontemporal_load((const unsigned*)&UM[(size_t)u * 4160 + 4096 + r]) : 0u; e1[c] = EM[2 * u]; e2[c] = EM[2 * u + 1]; }
#pragma unroll
                for (int c = 0; c < 32; ++c) { const int u = bh * 64 + half * 32 + c; const float d = e1[c] * e2[c];
                    *(unsigned*)&CP[(size_t)u * 4160 + r] = cvtpk(s0 * e1[c], s1 * e1[c]);
                    s0 = d * s0 + e2[c] * __uint_as_float(uu[c] << 16); s1 = d * s1 + e2[c] * __uint_as_float(uu[c] & 0xffff0000u);
                    if (nrow) { *(unsigned*)&CP[(size_t)u * 4160 + 4096 + r] = cvtpk(n0 * e1[c], n1 * e1[c]);
                        n0 = d * n0 + e2[c] * __uint_as_float(un[c] << 16); n1 = d * n1 + e2[c] * __uint_as_float(un[c] & 0xffff0000u); } } }
        } else { const int e = 2 * (p - 65536), bh = e >> 12, r = e & 4095, cc = r & 63; float s0 = 0.f, s1 = 0.f;
#pragma unroll
            for (int half = 0; half < 2; ++half) { unsigned uu[32]; f32x2_t e1[32], e2[32];
#pragma unroll
                for (int c = 0; c < 32; ++c) { const int u = bh * 64 + half * 32 + c; uu[c] = __builtin_nontemporal_load((const unsigned*)&UH[(size_t)u * 4096 + r]);
                    e1[c] = *(const f32x2_t*)&EH[(size_t)(2 * u) * 64 + cc]; e2[c] = *(const f32x2_t*)&EH[(size_t)(2 * u + 1) * 64 + cc]; }
#pragma unroll
                for (int c = 0; c < 32; ++c) { const int u = bh * 64 + half * 32 + c;
                    *(unsigned*)&SP[(size_t)u * 4096 + r] = cvtpk(s0 * e1[c].x, s1 * e1[c].y);
                    s0 = e1[c].x * e2[c].x * s0 + e2[c].x * __uint_as_float(uu[c] << 16); s1 = e1[c].y * e2[c].y * s1 + e2[c].y * __uint_as_float(uu[c] & 0xffff0000u); } }
        }
    }
}
template <int T> __device__ __forceinline__ void x3_unit(LAS unsigned char* wl, int u, int lane_, const bf16* U, const bf16* QK, const bf16* SPb, const float* nwt, bf16* Y) {
    constexpr int NVB = T == 0 ? 3 : 2, NROW = T == 0 ? 65 : 64;
    constexpr int QP = T == 0 ? 512 : NU, QO = T == 0 ? 0 : U_QH, KO = T == 0 ? 256 : U_FH;
    int lane = lane_; asm volatile("" : "+v"(lane));
    const int bh = u >> 6, c = u & 63, b = bh >> 2, hd = bh & 3, h = lane >> 5, cl = lane & 31; const size_t m0 = (size_t)b * S + c * 64;
    LAS unsigned char* Vt = wl;
    v4u vst[8];
    { const bf16* src = U + m0 * NU + (T == 0 ? U_VM : U_IH) + hd * 64;
#pragma unroll
      for (int i = 0; i < 8; ++i) vst[i] = *(const v4u*)(src + (size_t)(8 * i + (lane >> 3)) * NU + (lane & 7) * 8); }
    bf16x8 qf[2][4], kf[2][4], sf[NVB][4];
#pragma unroll
    for (int tb = 0; tb < 2; ++tb)
#pragma unroll
        for (int d0 = 0; d0 < 4; ++d0) { qf[tb][d0] = *(const bf16x8*)(QK + (m0 + 32 * tb + cl) * QP + QO + hd * 64 + 16 * d0 + 8 * h); kf[tb][d0] = *(const bf16x8*)(QK + (m0 + 32 * tb + cl) * QP + KO + hd * 64 + 16 * d0 + 8 * h); }
#pragma unroll
    for (int vb = 0; vb < NVB; ++vb) { const int row = (32 * vb + cl) < NROW ? (32 * vb + cl) : (NROW - 1);
#pragma unroll
        for (int d0 = 0; d0 < 4; ++d0) sf[vb][d0] = *(const bf16x8*)(SPb + ((size_t)u * NROW + row) * 64 + 16 * d0 + 8 * h); }
#pragma unroll
    for (int i = 0; i < 8; ++i) *(LAS v4u*)(Vt + (8 * i + (lane >> 3)) * 128 + (lane & 7) * 16) = vst[i];
    LDS_WAIT();
    const int lo = tr_lane_off(lane); const bf16x8 onef = ones_frag(lane);
    f32x4 nwv[2][4];
#pragma unroll
    for (int vb = 0; vb < 2; ++vb)
#pragma unroll
        for (int r4 = 0; r4 < 4; ++r4) nwv[vb][r4] = *(const f32x4*)(nwt + hd * 64 + 32 * vb + 8 * r4 + 4 * h);
#pragma unroll
    for (int tb = 0; tb < 2; ++tb) {
        const int t = 32 * tb + cl;
        const bf16* gp = U + (m0 + t) * NU + (T == 0 ? U_OM : U_GH) + hd * 64;
        v2u gu[2][4];
#pragma unroll
        for (int vb = 0; vb < 2; ++vb)
#pragma unroll
            for (int r4 = 0; r4 < 4; ++r4) gu[vb][r4] = *(const v2u*)(gp + 32 * vb + 8 * r4 + 4 * h);
        f32x16 acc[NVB];
#pragma unroll
        for (int vb = 0; vb < NVB; ++vb) {
#pragma unroll
            for (int r = 0; r < 16; ++r) acc[vb][r] = 0.f;
#pragma unroll
            for (int d0 = 0; d0 < 4; ++d0) acc[vb] = __builtin_amdgcn_mfma_f32_32x32x16_bf16(sf[vb][d0], qf[tb][d0], acc[vb], 0, 0, 0);
        }
#pragma unroll
        for (int sb = 0; sb <= tb; ++sb) {
            f32x16 st;
#pragma unroll
            for (int r = 0; r < 16; ++r) st[r] = 0.f;
#pragma unroll
            for (int d0 = 0; d0 < 4; ++d0) st = __builtin_amdgcn_mfma_f32_32x32x16_bf16(kf[sb][d0], qf[tb][d0], st, 0, 0, 0);
            if (sb == tb) {
#pragma unroll
                for (int r = 0; r < 16; ++r) if (crow(r, h) > cl) st[r] = 0.f;
            }
#pragma unroll
            for (int ks = 0; ks < 2; ++ks) {
                v4u pw; pw.x = cvtpk(st[8 * ks + 0], st[8 * ks + 1]); pw.y = cvtpk(st[8 * ks + 2], st[8 * ks + 3]); pw.z = cvtpk(st[8 * ks + 4], st[8 * ks + 5]); pw.w = cvtpk(st[8 * ks + 6], st[8 * ks + 7]);
                const bf16x8 pf = __builtin_bit_cast(bf16x8, pw);
#pragma unroll
                for (int vb = 0; vb < 2; ++vb) { const bf16x8 af = tr_frag(Vt + 128 * (32 * sb + 16 * ks) + 64 * vb + lo); acc[vb] = __builtin_amdgcn_mfma_f32_32x32x16_bf16(af, pf, acc[vb], 0, 0, 0); }
                if (T == 0) acc[NVB - 1] = __builtin_amdgcn_mfma_f32_32x32x16_bf16(onef, pf, acc[NVB - 1], 0, 0, 0);
            }
        }
        float sc = 1.0f;
        if (T == 0) { const float den = shl_from(acc[NVB - 1][0], cl); sc = 1.0f / fmaxf(fabsf(den), 1.0f); }
        float s1 = 0.f;
#pragma unroll
        for (int vb = 0; vb < 2; ++vb)
#pragma unroll
            for (int r = 0; r < 16; ++r) { acc[vb][r] *= sc; s1 += (T == 0) ? acc[vb][r] : acc[vb][r] * acc[vb][r]; }
        s1 += shx(s1, 32, lane);
        float mean = 0.f, rstd;
        if (T == 0) { mean = s1 * (1.0f / 64.0f); float s2 = 0.f;
#pragma unroll
            for (int vb = 0; vb < 2; ++vb)
#pragma unroll
                for (int r = 0; r < 16; ++r) { const float d = acc[vb][r] - mean; s2 += d * d; }
            s2 += shx(s2, 32, lane); rstd = __builtin_amdgcn_rsqf(s2 * (1.0f / 64.0f) + EPS); }
        else rstd = __builtin_amdgcn_rsqf(s1 * (1.0f / 64.0f) + EPS);
        bf16* yp = Y + (m0 + t) * D + (T == 0 ? Y_M : Y_H) + hd * 64;
#pragma unroll
        for (int vb = 0; vb < 2; ++vb)
#pragma unroll
            for (int r4 = 0; r4 < 4; ++r4) { const int dv = 32 * vb + 8 * r4 + 4 * h; const f32x4 w = nwv[vb][r4]; const v2u g2 = gu[vb][r4];
                float gv[4] = {bf2f(g2.x & 0xffffu), bf2f(g2.x >> 16), bf2f(g2.y & 0xffffu), bf2f(g2.y >> 16)}; float yv[4];
#pragma unroll
                for (int e = 0; e < 4; ++e) { const float gate = (T == 0) ? fsigmoid(gv[e]) : fsilu(gv[e]); yv[e] = (acc[vb][4 * r4 + e] - mean) * rstd * w[e] * gate; }
                v2u ov; ov.x = cvtpk(yv[0], yv[1]); ov.y = cvtpk(yv[2], yv[3]); *(v2u*)(yp + dv) = ov; }
    }
    LDS_WAIT();
}
#ifndef PROBE_UP
#define PROBE_UP 1
#endif
#ifndef PROBE_DOWN
#define PROBE_DOWN 1
#endif
#ifndef PROBE_INOUT
#define PROBE_INOUT 1
#endif
#ifndef PROBE_ATT
#define PROBE_ATT 1
#endif
#ifndef PROBE_X
#define PROBE_X 1
#endif
#ifndef PROBE_X1
#define PROBE_X1 PROBE_X
#endif
#ifndef PROBE_X2
#define PROBE_X2 PROBE_X
#endif
#ifndef PROBE_X3
#define PROBE_X3 PROBE_X
#endif
#ifndef PROBE_BAR
#define PROBE_BAR 1
#endif
#ifndef PROBE_THIN
#define PROBE_THIN 0
#endif
#ifndef PROBE_WCONV
#define PROBE_WCONV 1
#endif
#ifndef PROBE_ATT_ABL
#define PROBE_ATT_ABL 0
#endif
#ifndef MK_PER_PHASE
#define MK_PER_PHASE 0
#endif
constexpr int NWAVES = 8, NTHREADS = 512;
constexpr int RING_BYTES = 131072, LDSCTL_OFF = RING_BYTES, LDS_BYTES = 147456;
constexpr int CW_BAR = 4096;
constexpr size_t CTL_ZERO_BYTES = 64 * 1024;
constexpr int PH_PER_LAYER = 13, N_PHASES = 1 + DEPTH * PH_PER_LAYER;
struct Args { const float* in[18]; float* out; unsigned char* ws; int ph_lo, ph_hi; };
struct ArgsG { __attribute__((address_space(1))) const float* in[18]; __attribute__((address_space(1))) float* out; __attribute__((address_space(1))) unsigned char* ws; int ph_lo, ph_hi; };

__global__ void __launch_bounds__(NTHREADS, 2) mk_fwd(Args a) {
    extern __shared__ __attribute__((aligned(16))) unsigned char lds_raw[];
    LAS unsigned char* lds = (LAS unsigned char*)lds_raw;
    int tid = threadIdx.x, lane = tid & 63, wave = __builtin_amdgcn_readfirstlane(tid >> 6);
    const int G = gridDim.x, bx = blockIdx.x, NGW = G * NWAVES; int gw = bx * NWAVES + wave; const int wave_u = wave;
    typedef const __attribute__((address_space(4))) ArgsG* argp_t;
    argp_t ap = (argp_t)__builtin_amdgcn_kernarg_segment_ptr();
#define AS1(T, p) ((T*)(p))
#define P_ws AS1(unsigned char, ap->ws)
#define P_x AS1(const float, ap->in[0])
#define P_norm_w AS1(const float, ap->in[1])
#define P_w_in AS1(const float, ap->in[6])
#define P_w_out AS1(const float, ap->in[7])
#define P_conv_w AS1(const float, ap->in[8])
#define P_conv_b AS1(const float, ap->in[9])
#define P_igb AS1(const float, ap->in[10])
#define P_fgb AS1(const float, ap->in[11])
#define P_mnw AS1(const float, ap->in[12])
#define P_dlam AS1(const float, ap->in[13])
#define P_dnw AS1(const float, ap->in[14])
#define P_relb AS1(const float, ap->in[15])
#define P_lbl AS1(const float, ap->in[16])
#define P_hnw AS1(const float, ap->in[17])
#define P_out AS1(float, ap->out)
#define P_GW ((float*)(P_ws + WS_GW))
#define P_WI ((bf16*)(P_ws + WS_WI))
#define P_WO ((bf16*)(P_ws + WS_WO))
#define P_WIN ((bf16*)(P_ws + WS_WIN))
#define P_WOUT ((bf16*)(P_ws + WS_WOUT))
#define P_gates ((float*)(P_ws + WS_GATES))
#define P_RS ((float*)(P_ws + WS_RS))
#define P_XN ((bf16*)(P_ws + WS_XN))
#define P_U ((bf16*)(P_ws + WS_U))
#define P_HB P_U
#define P_HOUT ((bf16*)(P_ws + WS_HOUT))
#define P_Y ((bf16*)(P_ws + WS_Y))
#define P_QKM ((bf16*)(P_ws + WS_HOUT))
#define P_QKH P_U
#define P_UH ((bf16*)(P_ws + WS_HOUT + 32 * MiB))
#define P_SP ((bf16*)(P_ws + WS_WI))
#define P_UM ((bf16*)(P_ws + WS_MIX))
#define P_CP ((bf16*)(P_ws + WS_MIX + 33 * MiB))
#define P_EM ((float*)(P_ws + WS_MIX + 50 * MiB))
#define P_EH ((float*)(P_ws + WS_MIX + 51 * MiB))
    for (int u = tid; u < (LDS_BYTES - LDSCTL_OFF) / 4; u += NTHREADS) ((LAS unsigned*)(lds + LDSCTL_OFF))[u] = 0u;
    __syncthreads();
    XcdBarrier bar; bar.bar = (unsigned*)(P_ws + WS_CTL) + CW_BAR; bar.x = 0; bar.st = nullptr;
    if (!MK_PER_PHASE) bar = xcd_barrier_post((unsigned*)(P_ws + WS_CTL) + CW_BAR, (volatile LAS unsigned*)(lds + LDSCTL_OFF + 64), tid);
    const bool GRP = !MK_PER_PHASE && G == 256;
    if (GRP) grp_post((unsigned*)(P_ws + WS_CTL), bx, tid);
    const int lo = ap->ph_lo, hi = ap->ph_hi;
#define IN(k) (!MK_PER_PHASE || (lo <= (k) && (k) < hi))
#define GWV (GRP ? (((bx & 7) * (G >> 3) + (bx >> 3)) * NWAVES + wave_u) : gw)
#define SEAMG(k) do { if (!MK_PER_PHASE && IN(k) && IN((k) + 1)) { if (GRP) grp_barrier((unsigned*)(P_ws + WS_CTL), (unsigned*)(P_ws + WS_CTL) + CW_BAR, bx, G, (volatile LAS unsigned*)(lds + LDSCTL_OFF + 96), wave_u * 64 + lane_id_now()); \
        else xcd_barrier(bar, wave_u * 64 + lane_id_now()); } } while (0)
#define SEAM(k) do { if (!MK_PER_PHASE && IN(k) && IN((k) + 1)) for (int rb = 0; rb < PROBE_BAR; ++rb) xcd_barrier(bar, wave_u * 64 + lane_id_now()); } while (0)
    LAS float* wscr = (LAS float*)lds + wave * (64 * 33);
#define RELAUNDER() do { asm volatile("" : "+s"(ap)); int w_ = wave_u; asm volatile("" : "+s"(w_)); int l_ = lane_id_now(); wave = w_; lane = l_; tid = wave * 64 + lane; gw = bx * NWAVES + wave; wscr = (LAS float*)lds + wave * (64 * 33); } while (0)

    if (IN(0)) {
        thin_rows<0, false, false>(P_x, P_XN, nullptr, nullptr, 0.f, P_RS, nullptr, nullptr, nullptr, GWV, NGW, lane, GRP);
        for (int idx = bx * NTHREADS + tid; idx < DEPTH * 8 * D; idx += G * NTHREADS) { const int l = idx / (8 * D), r = idx % (8 * D), j = r / D, k = r % D;
            P_GW[idx] = P_norm_w[(size_t)(l * 6 + 2) * D + k] * P_w_in[(size_t)l * D * NIN + (size_t)k * NIN + 1024 + j]; }
        if (bx == 0 && tid < DEPTH) { float li; const float lam = diff_lambda(P_dlam + tid * 256, tid, li); P_GW[DEPTH * 8 * D + 2 * tid] = lam; P_GW[DEPTH * 8 * D + 2 * tid + 1] = li; }
        for (int rw = 0; rw < PROBE_WCONV; ++rw) wconv_items<1>(AS1(const float, ap->in[2]), D, 2 * FF, 2 * FF, P_norm_w, P_WI, wscr, gw, NGW, lane);
        for (int rw = 0; rw < PROBE_WCONV; ++rw) wconv_items<0>(AS1(const float, ap->in[3]), FF, D, D, nullptr, P_WO, wscr, gw, NGW, lane);
    }
    SEAM(0);
    for (int l = 0; l < DEPTH; ++l) {
        const int pb = 1 + l * PH_PER_LAYER;
        RELAUNDER();

        for (int half = 0; half < 2; ++half) {
            const int pf = pb + (half ? 10 : 0);
            if (IN(pf)) for (int rep = 0; rep < PROBE_UP; ++rep) { RELAUNDER(); pg8::Gemm g{P_XN, P_WI, M, 2 * FF, D}; pg8::StaticOrder So; So.init(M, 2 * FF, G, bx); pg8::EpiSwiGLU E{P_HB, FF, P_RS};
                pg8::gemm_phase<pg8::EpiSwiGLU, pg8::StaticOrder, true, true>(lds, g, So, E, tid); }
            SEAMG(pf);
            if (IN(pf + 1)) for (int rep = 0; rep < PROBE_DOWN; ++rep) { RELAUNDER(); pg8::Gemm g{P_HB, P_WO, M, D, FF}; pg8::StaticOrder So; So.init(M, D, G, bx); pg8::EpiBf16 E{P_HOUT, D, nullptr, 0, 0, 1.0f};
                pg8::gemm_phase<pg8::EpiBf16, pg8::StaticOrder, true, true>(lds, g, So, E, tid); }
            if (half == 0) SEAMG(pf + 1); else SEAM(pf + 1);
            if (half == 0) {
                if (IN(pb + 2)) { RELAUNDER();
                    LAS float* gwl = (LAS float*)(lds + 73728);
                    for (int i = tid; i < 8 * D / 4; i += NTHREADS) *(LAS f32x4*)(gwl + 4 * i) = *(const f32x4*)(P_GW + (size_t)l * 8 * D + 4 * i);
                    __syncthreads();
                    thin_rows<1, true, false>(nullptr, P_XN, P_HOUT, P_norm_w + (size_t)l * 6 * D + 1 * D, 0.5f, P_RS, nullptr, gwl, P_gates, GWV, NGW, lane, GRP);
                    for (int rw = 0; rw < PROBE_WCONV; ++rw) wconv_items<2>(P_w_in + (size_t)l * D * NIN, D, NIN, NU, P_norm_w + (size_t)l * 6 * D + 2 * D, P_WIN, wscr, gw, NGW, lane);
                    for (int rw = 0; rw < PROBE_WCONV; ++rw) wconv_items<0>(P_w_out + (size_t)l * D * D, D, D, D, nullptr, P_WOUT, wscr, gw, NGW, lane);
                }
                SEAM(pb + 2);
                if (IN(pb + 3)) for (int rep = 0; rep < PROBE_INOUT; ++rep) { RELAUNDER(); pg8::Gemm g{P_XN, P_WIN, M, NU, D}; pg8::StaticOrder So; So.init(M, NU, G, bx); pg8::EpiBf16RS E{P_U, NU, P_RS, U_QD / 256, U_KD / 256, 0.125f * 1.4426950408889634f};
                    pg8::gemm_phase<pg8::EpiBf16RS, pg8::StaticOrder, true, true>(lds, g, So, E, tid); }
                SEAMG(pb + 3);
                for (int mp = 0; mp < 2; ++mp) { const bool chunk_pass = GRP ? ((((bx ^ mp) & 1) == 0)) : (mp == 0);
                if (chunk_pass) {
                if (IN(pb + 4)) for (int rep = 0; rep < PROBE_X1; ++rep) { RELAUNDER();
                    LAS unsigned char* wl = lds + wave * 16384;
                    for (int u = GWV; u < 2048; u += NGW) x1_mlstm(wl, u, lane, P_U, P_gates, P_conv_w + (size_t)l * 4 * 512, P_conv_b + (size_t)l * 512, P_igb + l * 4, P_fgb + l * 4, P_QKM, P_UM, P_EM);
                    for (int u = GWV; u < 2048; u += NGW) x1_hgrn(wl, u, lane, P_U, P_lbl, l, P_QKH, P_UH, P_EH);
                }
                SEAMG(pb + 4);
                if (IN(pb + 5)) for (int rep = 0; rep < PROBE_X2; ++rep) { RELAUNDER(); x2_scan(GRP ? (((bx >> 3) < 16 ? 0 : 65536) + 8192 * (bx & 7) + ((bx >> 3) & 15) * NTHREADS + tid) : bx * NTHREADS + tid, G * NTHREADS, P_UM, P_EM, P_CP, P_UH, P_EH, P_SP); }
                SEAMG(pb + 5);
                if (IN(pb + 6)) for (int rep = 0; rep < PROBE_X3; ++rep) { RELAUNDER();
                    LAS unsigned char* wl = lds + wave * 16384;
                    for (int u = GWV; u < 2048; u += NGW) x3_unit<0>(wl, u, lane, P_U, P_QKM, P_CP, P_mnw + l * 256, P_Y);
                    for (int u = GWV; u < 2048; u += NGW) x3_unit<1>(wl, u, lane, P_U, P_QKH, P_SP, P_hnw + l * 256, P_Y);
                }
                } else {
                if (IN(pb + 7)) for (int rep = 0; rep < PROBE_ATT; ++rep) { RELAUNDER();
                    const int vcu = (G % 8 == 0) ? (bx & 7) * (G >> 3) + (bx >> 3) : bx;
                    for (int i = vcu; i < 1024; i += G) { int v = i & 255, k = i >> 8; const int s8 = v & 7;
                        int qb = k == 0 ? s8 : (k == 1 ? 15 - s8 : (k == 2 ? 16 + s8 : 31 - s8));
                        if (G == 256) { const int xw = bx >> 3, jj = xw & 15; v = 8 * (4 * (bx & 7) + (xw >> 4) + 2 * (k >> 1)); qb = (k & 1) ? 31 - jj : jj; }
                        ph_attn_unit<0>(lds, v >> 3, qb, P_U, P_GW + DEPTH * 8 * D + 2 * l, l, P_dnw + l * 512, P_relb, P_Y, wave_u);
#if PROBE_ATT_ABL
                        ph_attn_unit<PROBE_ATT_ABL>(lds, v >> 3, qb, P_U, P_GW + DEPTH * 8 * D + 2 * l, l, P_dnw + l * 512, P_relb, (bf16*)(P_ws + WS_HOUT), wave_u);
#endif
                    }
                }
                }
                __syncthreads();
                }
                SEAM(pb + 7);
                if (IN(pb + 8)) for (int rep = 0; rep < PROBE_INOUT; ++rep) { RELAUNDER(); pg8::Gemm g{P_Y, P_WOUT, M, D, D}; pg8::StaticOrder So; So.init(M, D, G, bx); pg8::EpiBf16 E{P_HOUT, D, nullptr, 0, 0, 1.0f};
                    pg8::gemm_phase<pg8::EpiBf16, pg8::StaticOrder, true, true>(lds, g, So, E, tid); }
                SEAMG(pb + 8);
                if (IN(pb + 9)) { RELAUNDER();
                    thin_rows<1, false, false>(nullptr, P_XN, P_HOUT, P_norm_w + (size_t)l * 6 * D + 3 * D, 1.0f, P_RS, nullptr, nullptr, nullptr, GWV, NGW, lane, GRP);
                    for (int rw = 0; rw < PROBE_WCONV; ++rw) wconv_items<1>(AS1(const float, ap->in[4]) + (size_t)l * D * 2 * FF, D, 2 * FF, 2 * FF, P_norm_w + (size_t)l * 6 * D + 4 * D, P_WI, wscr, gw, NGW, lane);
                    for (int rw = 0; rw < PROBE_WCONV; ++rw) wconv_items<0>(AS1(const float, ap->in[5]) + (size_t)l * FF * D, FF, D, D, nullptr, P_WO, wscr, gw, NGW, lane);
                }
                SEAM(pb + 9);
            } else {
                if (IN(pb + 12)) { RELAUNDER();
                    if (l + 1 < DEPTH) thin_rows<1, false, false>(nullptr, P_XN, P_HOUT, P_norm_w + (size_t)l * 6 * D + 5 * D, 0.5f, P_RS, nullptr, nullptr, nullptr, GWV, NGW, lane, GRP);
                    else thin_rows<1, false, true>(nullptr, P_XN, P_HOUT, P_norm_w + (size_t)l * 6 * D + 5 * D, 0.5f, nullptr, P_out, nullptr, nullptr, GWV, NGW, lane, GRP);
                    if (l + 1 < DEPTH) {
                        for (int rw = 0; rw < PROBE_WCONV; ++rw) wconv_items<1>(AS1(const float, ap->in[2]) + (size_t)(l + 1) * D * 2 * FF, D, 2 * FF, 2 * FF, P_norm_w + (size_t)l * 6 * D + 6 * D, P_WI, wscr, gw, NGW, lane);
                        for (int rw = 0; rw < PROBE_WCONV; ++rw) wconv_items<0>(AS1(const float, ap->in[3]) + (size_t)(l + 1) * FF * D, FF, D, D, nullptr, P_WO, wscr, gw, NGW, lane);
                    }
                }
                SEAM(pb + 12);
            }
        }
    }
#undef IN
#undef SEAM
#undef P_ws
#undef P_x
#undef P_norm_w
#undef P_w_in
#undef P_w_out
#undef P_conv_w
#undef P_conv_b
#undef P_igb
#undef P_fgb
#undef P_mnw
#undef P_dlam
#undef P_dnw
#undef P_relb
#undef P_lbl
#undef P_hnw
#undef P_out
#undef P_GW
#undef P_WI
#undef P_WO
#undef P_WIN
#undef P_WOUT
#undef P_gates
#undef P_RS
#undef P_XN
#undef P_U
#undef P_HB
#undef P_HOUT
#undef P_Y
#undef P_QKM
#undef P_QKH
#undef P_UH
#undef P_SP
#undef P_UM
#undef P_CP
#undef P_EM
#undef P_EH
}

extern "C" void kernel_launch(void* const* d_in, const int* in_sizes, int n_in, void* d_out, int out_size, void* d_ws, size_t ws_size, hipStream_t stream) {
    static int grid = 0;
    if (grid == 0) {
        if (n_in != 18 || in_sizes[0] != M * D || out_size != M * D || ws_size < WS_END) { fprintf(stderr, "kernel_launch: unexpected shapes n_in %d in0 %d out %d ws %zu\n", n_in, n_in > 0 ? in_sizes[0] : -1, out_size, ws_size); grid = -1; return; }
        int dev = 0, cus = 0, per_cu = 0;
        if (hipGetDevice(&dev) != hipSuccess || hipDeviceGetAttribute(&cus, hipDeviceAttributeMultiprocessorCount, dev) != hipSuccess) { grid = -1; return; }
        if (hipFuncSetAttribute((const void*)mk_fwd, hipFuncAttributeMaxDynamicSharedMemorySize, LDS_BYTES) != hipSuccess) { fprintf(stderr, "kernel_launch: hipFuncSetAttribute failed\n"); grid = -1; return; }
        if (hipOccupancyMaxActiveBlocksPerMultiprocessor(&per_cu, (const void*)mk_fwd, NTHREADS, LDS_BYTES) != hipSuccess || per_cu < 1) fprintf(stderr, "kernel_launch: occupancy query says %d\n", per_cu);
        (void)hipGetLastError();
        grid = cus;
    }
    if (grid < 0) return;
    if (hipMemsetAsync((char*)d_ws + WS_CTL, 0, CTL_ZERO_BYTES, stream) != hipSuccess) return;
    Args a{};
    for (int i = 0; i < 18; ++i) a.in[i] = (const float*)d_in[i];
    a.out = (float*)d_out; a.ws = (unsigned char*)d_ws;
#if MK_PER_PHASE
    for (int p = 0; p < N_PHASES; ++p) { a.ph_lo = p; a.ph_hi = p + 1; hipLaunchKernelGGL(mk_fwd, dim3(grid), dim3(NTHREADS), LDS_BYTES, stream, a); }
#else
    a.ph_lo = 0; a.ph_hi = N_PHASES;
    hipLaunchKernelGGL(mk_fwd, dim3(grid), dim3(NTHREADS), LDS_BYTES, stream, a);
#endif
}
```
